# Optimizing an MI355X kernel written in HIP

```python
import jax, jax.numpy as jnp
from jax import lax
import numpy as np

D_MODEL = 1024
BATCH = 4
SEQ = 4096
DEPTH = 1

LRU_WIDTH = D_MODEL
LRU_HEADS = 4
LRU_HEAD_DIM = LRU_WIDTH // LRU_HEADS
CONV_WIDTH = 4
LRU_C = 8.0
SGU_WIDTH = D_MODEL
SGU_GROUPS = 4
SGU_GROUP_DIM = SGU_WIDTH // SGU_GROUPS
CHUNK = 128
D_FF = 4 * D_MODEL
NORM_EPS = 1e-6
LN_EPS = 1e-5
OFF_XA = 0
OFF_GA = OFF_XA + LRU_WIDTH
OFF_U = OFF_GA + LRU_WIDTH
OFF_V = OFF_U + SGU_WIDTH
OFF_MA = OFF_V + SGU_WIDTH
OFF_MB = OFF_MA + D_MODEL
D_IN = OFF_MB + D_MODEL

kernel_name = "hybrid_rglru_sgu_gated_block"


def rms_norm(x, g):
    xf = x.astype(jnp.float32)
    y = xf * lax.rsqrt(jnp.mean(xf * xf, axis=-1, keepdims=True) + NORM_EPS)
    return (y * g.astype(jnp.float32)).astype(x.dtype)


def layer_norm(x, g, b):
    xf = x.astype(jnp.float32)
    mu = jnp.mean(xf, axis=-1, keepdims=True)
    var = jnp.mean(jnp.square(xf - mu), axis=-1, keepdims=True)
    y = (xf - mu) * lax.rsqrt(var + LN_EPS)
    return (y * g.astype(jnp.float32) + b.astype(jnp.float32)).astype(x.dtype)


def causal_depthwise_conv(x, w, b):
    k_w = w.shape[0]
    s = x.shape[1]
    xp = jnp.pad(x, ((0, 0), (k_w - 1, 0), (0, 0)))
    out = b
    for k in range(k_w):
        out = out + xp[:, k_w - 1 - k:k_w - 1 - k + s] * w[k]
    return out


def rg_lru(x, w_r, b_r, w_i, b_i, lam):
    bsz, s, c = x.shape
    xh = x.reshape(bsz, s, LRU_HEADS, LRU_HEAD_DIM)
    r = jax.nn.sigmoid(jnp.einsum('bshi,hij->bshj', xh, w_r) + b_r).reshape(bsz, s, c)
    i = jax.nn.sigmoid(jnp.einsum('bshi,hij->bshj', xh, w_i) + b_i).reshape(bsz, s, c)
    log_a = -LRU_C * r.astype(jnp.float32) * jax.nn.softplus(-lam.astype(jnp.float32))
    a = jnp.exp(log_a)
    mult = jnp.sqrt(-jnp.expm1(2.0 * log_a))
    bx = x.astype(jnp.float32) * i.astype(jnp.float32) * mult

    def combine(left, right):
        a_l, b_l = left
        a_r, b_r2 = right
        return a_l * a_r, a_r * b_l + b_r2

    _, h = lax.associative_scan(combine, (a, bx), axis=1)
    return h.astype(x.dtype)


def chunked_spatial_gating(u, v, ln_g, ln_b, w_s, b_s):
    bsz, s, c = v.shape
    n_chunks = s // CHUNK
    v = layer_norm(v, ln_g, ln_b)
    vc = v.reshape(bsz, n_chunks, CHUNK, SGU_GROUPS, SGU_GROUP_DIM)
    mask = jnp.tril(jnp.ones((CHUNK, CHUNK), dtype=w_s.dtype))
    sp = jnp.einsum('gts,bnsgc->bntgc', w_s * mask, vc) + jnp.transpose(b_s)[:, :, None]
    return u * sp.reshape(bsz, s, c)


def setup_inputs(seed: int = 0) -> dict:
    key = jax.random.key(seed)
    ks = jax.random.split(key, 24)
    f32 = jnp.float32
    nrm = lambda k, shape, scale: jax.random.normal(k, shape, f32) * scale
    x = jax.random.normal(ks[0], (BATCH, SEQ, D_MODEL), f32)
    norm_mix_g = 1.0 + nrm(ks[1], (DEPTH, D_MODEL), 0.02)
    w_in = nrm(ks[2], (DEPTH, D_MODEL, D_IN), D_MODEL ** -0.5)
    conv_w = nrm(ks[3], (DEPTH, CONV_WIDTH, LRU_WIDTH), CONV_WIDTH ** -0.5)
    conv_b = nrm(ks[4], (DEPTH, LRU_WIDTH), 0.01)
    w_rgate = nrm(ks[5], (DEPTH, LRU_HEADS, LRU_HEAD_DIM, LRU_HEAD_DIM), LRU_HEAD_DIM ** -0.5)
    b_rgate = nrm(ks[6], (DEPTH, LRU_HEADS, LRU_HEAD_DIM), 0.01)
    w_igate = nrm(ks[7], (DEPTH, LRU_HEADS, LRU_HEAD_DIM, LRU_HEAD_DIM), LRU_HEAD_DIM ** -0.5)
    b_igate = nrm(ks[8], (DEPTH, LRU_HEADS, LRU_HEAD_DIM), 0.01)
    a_c = jax.random.uniform(ks[9], (DEPTH, LRU_WIDTH), f32, 0.9, 0.999)
    sig = a_c ** (1.0 / LRU_C)
    lru_lambda = jnp.log(sig) - jnp.log1p(-sig)
    w_out_a = nrm(ks[10], (DEPTH, LRU_WIDTH, D_MODEL), LRU_WIDTH ** -0.5)
    sgu_ln_g = 1.0 + nrm(ks[11], (DEPTH, SGU_WIDTH), 0.02)
    sgu_ln_b = nrm(ks[12], (DEPTH, SGU_WIDTH), 0.01)
    sgu_w_s = nrm(ks[13], (DEPTH, SGU_GROUPS, CHUNK, CHUNK), CHUNK ** -0.5)
    sgu_b_s = 1.0 + nrm(ks[14], (DEPTH, SGU_GROUPS, CHUNK), 0.01)
    w_out_b = nrm(ks[15], (DEPTH, SGU_WIDTH, D_MODEL), SGU_WIDTH ** -0.5)
    w_out = nrm(ks[16], (DEPTH, D_MODEL, D_MODEL), D_MODEL ** -0.5)
    norm_mlp_g = 1.0 + nrm(ks[17], (DEPTH, D_MODEL), 0.02)
    w_up = nrm(ks[18], (DEPTH, D_MODEL, D_FF), D_MODEL ** -0.5)
    w_down = nrm(ks[19], (DEPTH, D_FF, D_MODEL), D_FF ** -0.5)
    norm_final_g = 1.0 + nrm(ks[20], (D_MODEL,), 0.02)
    return {"x": x, "norm_mix_g": norm_mix_g, "w_in": w_in, "conv_w": conv_w, "conv_b": conv_b,
            "w_rgate": w_rgate, "b_rgate": b_rgate, "w_igate": w_igate, "b_igate": b_igate,
            "lru_lambda": lru_lambda, "w_out_a": w_out_a, "sgu_ln_g": sgu_ln_g, "sgu_ln_b": sgu_ln_b,
            "sgu_w_s": sgu_w_s, "sgu_b_s": sgu_b_s, "w_out_b": w_out_b, "w_out": w_out,
            "norm_mlp_g": norm_mlp_g, "w_up": w_up, "w_down": w_down, "norm_final_g": norm_final_g}


def reference(x, norm_mix_g, w_in, conv_w, conv_b, w_rgate, b_rgate, w_igate, b_igate,
              lru_lambda, w_out_a, sgu_ln_g, sgu_ln_b, sgu_w_s, sgu_b_s, w_out_b, w_out,
              norm_mlp_g, w_up, w_down, norm_final_g):
    h = x
    for l in range(DEPTH):
        n = rms_norm(h, norm_mix_g[l])
        z = n @ w_in[l]
        xa = z[..., OFF_XA:OFF_GA]
        ga = z[..., OFF_GA:OFF_U]
        ub = z[..., OFF_U:OFF_V]
        vb = z[..., OFF_V:OFF_MA]
        ma = z[..., OFF_MA:OFF_MB]
        mb = z[..., OFF_MB:D_IN]
        xa = causal_depthwise_conv(xa, conv_w[l], conv_b[l])
        ya = rg_lru(xa, w_rgate[l], b_rgate[l], w_igate[l], b_igate[l], lru_lambda[l]) * jax.nn.gelu(ga)
        yb = chunked_spatial_gating(jax.nn.gelu(ub), jax.nn.gelu(vb), sgu_ln_g[l], sgu_ln_b[l],
                                    sgu_w_s[l], sgu_b_s[l])
        merged = jax.nn.sigmoid(ma) * (ya @ w_out_a[l]) + jax.nn.sigmoid(mb) * (yb @ w_out_b[l])
        h = h + merged @ w_out[l]
        n2 = rms_norm(h, norm_mlp_g[l])
        h = h + jnp.square(jax.nn.relu(n2 @ w_up[l])) @ w_down[l]
    return rms_norm(h, norm_final_g)
```

```cpp
#include <hip/hip_runtime.h>
#include <hip/hip_cooperative_groups.h>
#include <cstdio>
#include <cstdint>
namespace cg = cooperative_groups;
namespace pg8 {
#define PG8_LAS __attribute__((address_space(3)))
typedef unsigned short bf16_t;
typedef short bf16x8 __attribute__((ext_vector_type(8)));
typedef float f32x4 __attribute__((ext_vector_type(4)));
typedef unsigned u32x4 __attribute__((ext_vector_type(4)));
constexpr int BM = 256, BK = 64, HALF = 128, HTB = HALF * BK * 2  , STAGE_BYTES = 8 * HTB, NXCD = 8, WGM = 8;

__host__ __device__ __forceinline__ int lds_byte(int r, int c) { const int st = (r >> 4) * 2 + (c >> 5), rr = r & 15, cc = c & 31, ob = rr * 64 + cc * 2; return st * 1024 + (ob ^ (((ob >> 9) & 1) << 5)); }
__host__ __device__ __forceinline__ void stage_rc(int b, int& R, int& C) { const int st = b / 1024, sb = b % 1024, swz = sb ^ (((sb >> 9) & 1) << 5); R = (st >> 1) * 16 + swz / 64; C = (st & 1) * 32 + (swz % 64) / 2; }
__host__ __device__ __forceinline__ int perm32(int rho) { const int n = rho >> 4, i = rho & 15; return 8 * (i >> 2) + 4 * n + (i & 3); }

struct Unit { int pm, pn; };
struct Gemm { const bf16_t* A; const bf16_t* Bt; int M, N, K; };

struct StaticOrder {
    int nM, nN, nwg, G, c, rot, nround;
    __host__ __device__ void init(int M, int N, int G_, int c_, int rot_ = 0) { nM = M / BM; nN = N / BM; nwg = nM * nN; G = G_; c = c_; nround = nwg / G; rot = (nwg % G == 0 && nround > 1) ? rot_ % nround : 0; }
    __host__ __device__ bool next(int i, Unit& u) const {
        if ((long)i * G + c >= nwg) return false;
        int ii = i + rot; if (rot && ii >= nround) ii -= nround;
        const long L = (long)ii * G + c;
        int wgid = (int)L; { const int q = nwg / NXCD, r = nwg % NXCD, xcd = wgid % NXCD, off = wgid / NXCD; wgid = (xcd < r ? xcd * (q + 1) : r * (q + 1) + (xcd - r) * q) + off; }
        const int nig = WGM * nN, gid = wgid / nig, fm = gid * WGM, gsz = (nM - fm) < WGM ? (nM - fm) : WGM;
        u.pm = fm + ((wgid % nig) % gsz); u.pn = (wgid % nig) / gsz; return true;
    }
    __device__ __forceinline__ void a_ready(const Unit&) const {}
    __device__ __forceinline__ void done(const Unit&) const {}
};

__device__ __forceinline__ unsigned cvt_pk_bf16(float lo, float hi) { unsigned r; asm volatile("v_cvt_pk_bf16_f32 %0, %1, %2" : "=v"(r) : "v"(lo), "v"(hi)); return r; }
__device__ __forceinline__ float sigmoid_f(float x) { return __builtin_amdgcn_rcpf(1.0f + __builtin_amdgcn_exp2f(-1.4426950409f * x)); }
__device__ __forceinline__ float gelu_tanh_f(float x) { const float t = x * (1.5957691216f + 0.0713548163f * x * x); return x * __builtin_amdgcn_rcpf(1.0f + __builtin_amdgcn_exp2f(-1.4426950409f * t)); }
typedef float f32x2e __attribute__((ext_vector_type(2)));
__device__ __forceinline__ f32x2e gelu_tanh_pk(f32x2e x) { const f32x2e x2 = x * x; const f32x2e t = x * (x2 * (-0.1029432407f) + (-2.3022081925f));
    f32x2e e; e.x = __builtin_amdgcn_exp2f(t.x); e.y = __builtin_amdgcn_exp2f(t.y); const f32x2e d = e + 1.0f; f32x2e r; r.x = __builtin_amdgcn_rcpf(d.x); r.y = __builtin_amdgcn_rcpf(d.y); return x * r; }
__device__ __forceinline__ f32x2e sigmoid_pk(f32x2e x) { const f32x2e t = x * (-1.4426950409f); f32x2e e; e.x = __builtin_amdgcn_exp2f(t.x); e.y = __builtin_amdgcn_exp2f(t.y); const f32x2e d = e + 1.0f;
    f32x2e r; r.x = __builtin_amdgcn_rcpf(d.x); r.y = __builtin_amdgcn_rcpf(d.y); return r; }
__device__ __forceinline__ float bf_lo(unsigned w) { return __uint_as_float(w << 16); }
__device__ __forceinline__ float bf_hi(unsigned w) { return __uint_as_float(w & 0xffff0000u); }
__device__ __forceinline__ u32x4 pack8(const f32x4 v0, const f32x4 v1) { u32x4 w; w.x = cvt_pk_bf16(v0[0], v0[1]); w.y = cvt_pk_bf16(v0[2], v0[3]); w.z = cvt_pk_bf16(v1[0], v1[1]); w.w = cvt_pk_bf16(v1[2], v1[3]); return w; }

struct EpiZ {
    static constexpr bool PERM = true, AFTER_DRAIN = false, MIDK = false;
    bf16_t* Z4; bf16_t* ZG; float* LNS;
    template <int MODE> __device__ __forceinline__ void body(const f32x4 (&acc)[2][2][4][2], int pn, int row0, int wc, int fq) const {
        typedef unsigned u32x2v __attribute__((ext_vector_type(2)));
        const int col0 = (MODE == 3 ? (pn - 16) * BM : pn * BM) + wc * 32 + 8 * fq;
#pragma unroll
        for (int ai = 0; ai < 2; ++ai)
#pragma unroll
            for (int m = 0; m < 4; ++m) { const size_t row = (size_t)(row0 + ai * HALF + m * 16); float s = 0.f, q = 0.f;
#pragma unroll
                for (int bj = 0; bj < 2; ++bj) { f32x4 v0 = acc[ai][bj][m][0], v1 = acc[ai][bj][m][1];
                    if (MODE == 3) {
                        unsigned w0 = 0u, w1 = 0u;
#pragma unroll
                        for (int j = 0; j < 4; j += 2) { const f32x2e s0 = sigmoid_pk((f32x2e){v0[j], v0[j + 1]}) * 255.0f, s1 = sigmoid_pk((f32x2e){v1[j], v1[j + 1]}) * 255.0f;
                            w0 = __builtin_amdgcn_cvt_pk_u8_f32(fmaxf(__builtin_rintf(s0.x), 1.0f), j, w0); w0 = __builtin_amdgcn_cvt_pk_u8_f32(fmaxf(__builtin_rintf(s0.y), 1.0f), j + 1, w0);
                            w1 = __builtin_amdgcn_cvt_pk_u8_f32(fmaxf(__builtin_rintf(s1.x), 1.0f), j, w1); w1 = __builtin_amdgcn_cvt_pk_u8_f32(fmaxf(__builtin_rintf(s1.y), 1.0f), j + 1, w1); }
                        *(u32x2v*)((unsigned char*)ZG + row * 2048 + col0 + bj * HALF) = (u32x2v){w0, w1};
                    } else {
                        if (MODE >= 1) {
#pragma unroll
                            for (int j = 0; j < 4; j += 2) { const f32x2e a = gelu_tanh_pk((f32x2e){v0[j], v0[j + 1]}), b = gelu_tanh_pk((f32x2e){v1[j], v1[j + 1]}); v0[j] = a.x; v0[j + 1] = a.y; v1[j] = b.x; v1[j + 1] = b.y; } }
                        if (MODE == 2) { s += (v0[0] + v0[1]) + (v0[2] + v0[3]) + (v1[0] + v1[1]) + (v1[2] + v1[3]);
                            q += (v0[0] * v0[0] + v0[1] * v0[1]) + (v0[2] * v0[2] + v0[3] * v0[3]) + (v1[0] * v1[0] + v1[1] * v1[1]) + (v1[2] * v1[2] + v1[3] * v1[3]); }
                        *(u32x4*)(Z4 + row * 4096 + col0 + bj * HALF) = pack8(v0, v1); } }
                if (MODE == 2) { s += __shfl_xor(s, 16); s += __shfl_xor(s, 32); q += __shfl_xor(q, 16); q += __shfl_xor(q, 32);
                    if (fq == 0) { float* p = LNS + row * 2; __hip_atomic_fetch_add(p, s, __ATOMIC_RELAXED, __HIP_MEMORY_SCOPE_AGENT); __hip_atomic_fetch_add(p + 1, q, __ATOMIC_RELAXED, __HIP_MEMORY_SCOPE_AGENT); } } }
    }
    __device__ __forceinline__ void operator()(const f32x4 (&acc)[2][2][4][2], const Unit& u, int wr, int wc, int fr, int fq) const {
        const int sec = u.pn >> 2, row0 = u.pm * BM + wr * 64 + fr;
        if (sec == 0) body<0>(acc, u.pn, row0, wc, fq);
        else if (sec < 3) body<1>(acc, u.pn, row0, wc, fq);
        else if (sec == 3) body<2>(acc, u.pn, row0, wc, fq);
        else body<3>(acc, u.pn, row0, wc, fq);
    }
};
struct EpiMerge2 {
    static constexpr bool PERM = true, AFTER_DRAIN = false, MIDK = true;
    const unsigned char* G; bf16_t* O;
    typedef unsigned u32x2v __attribute__((ext_vector_type(2)));
    static __device__ __forceinline__ f32x4 ub4(unsigned w) { return (f32x4){(float)(w & 0xffu), (float)((w >> 8) & 0xffu), (float)((w >> 16) & 0xffu), (float)(w >> 24)}; }
    __device__ __forceinline__ void mid(f32x4 (&acc)[2][2][4][2], const Unit& u, int wr, int wc, int fr, int fq) const {
        int row0 = u.pm * BM + wr * 64 + fr, col0 = u.pn * BM + wc * 32 + 8 * fq;
        asm volatile("" : "+v"(row0), "+v"(col0));
#pragma unroll
        for (int ai = 0; ai < 2; ++ai)
#pragma unroll
            for (int m = 0; m < 4; ++m) { const unsigned char* gp = G + (size_t)(row0 + ai * HALF + m * 16) * 2048 + col0;
#pragma unroll
                for (int bj = 0; bj < 2; ++bj) { const u32x2v a = *(const u32x2v*)(gp + bj * HALF), b = *(const u32x2v*)(gp + 1024 + bj * HALF);
                    const f32x4 a0 = ub4(a.x), a1 = ub4(a.y), b0 = ub4(b.x), b1 = ub4(b.y);
#pragma unroll
                    for (int j = 0; j < 4; ++j) { acc[ai][bj][m][0][j] *= a0[j] * __builtin_amdgcn_rcpf(b0[j]); acc[ai][bj][m][1][j] *= a1[j] * __builtin_amdgcn_rcpf(b1[j]); }
                    asm volatile("" ::: "memory"); } }
    }
    __device__ __forceinline__ void operator()(const f32x4 (&acc)[2][2][4][2], const Unit& u, int wr, int wc, int fr, int fq) const {
        const int row0 = u.pm * BM + wr * 64 + fr, col0 = u.pn * BM + wc * 32 + 8 * fq;
        u32x2v gbv[2][4][2];
#pragma unroll
        for (int ai = 0; ai < 2; ++ai)
#pragma unroll
            for (int m = 0; m < 4; ++m)
#pragma unroll
                for (int bj = 0; bj < 2; ++bj) gbv[ai][m][bj] = *(const u32x2v*)(G + (size_t)(row0 + ai * HALF + m * 16) * 2048 + 1024 + col0 + bj * HALF);
#pragma unroll
        for (int ai = 0; ai < 2; ++ai)
#pragma unroll
            for (int m = 0; m < 4; ++m) { const size_t row = (size_t)(row0 + ai * HALF + m * 16);
#pragma unroll
                for (int bj = 0; bj < 2; ++bj) { const int c = col0 + bj * HALF; const u32x2v b = gbv[ai][m][bj];
                    const f32x4 b0 = ub4(b.x) * (1.0f / 255.0f), b1 = ub4(b.y) * (1.0f / 255.0f);
                    *(u32x4*)(O + row * 1024 + c) = pack8(acc[ai][bj][m][0] * b0, acc[ai][bj][m][1] * b1); } }
    }
};
struct EpiH1 {
    static constexpr bool PERM = true, AFTER_DRAIN = false, MIDK = false;
    const float* X; float* H; bf16_t* HB; float* SS; int wH;
    template <bool WH> __device__ __forceinline__ void body(const f32x4 (&acc)[2][2][4][2], const Unit& u, int wr, int wc, int fr, int fq) const {
        const int row0 = u.pm * BM + wr * 64 + fr, col0 = u.pn * BM + wc * 32 + 8 * fq;
#pragma unroll
        for (int ai = 0; ai < 2; ++ai)
#pragma unroll
          for (int mh = 0; mh < 4; mh += 2) {
            f32x4 xv[2][2][2];
#pragma unroll
            for (int m = 0; m < 2; ++m)
#pragma unroll
                for (int bj = 0; bj < 2; ++bj) { const float* xp = X + (size_t)(row0 + ai * HALF + (mh + m) * 16) * 1024 + col0 + bj * HALF; xv[m][bj][0] = *(const f32x4*)xp; xv[m][bj][1] = *(const f32x4*)(xp + 4); }
#pragma unroll
            for (int m = 0; m < 2; ++m) { const size_t row = (size_t)(row0 + ai * HALF + (mh + m) * 16); float s = 0.f;
#pragma unroll
                for (int bj = 0; bj < 2; ++bj) { const int c = col0 + bj * HALF;
                    const f32x4 v0 = xv[m][bj][0] + acc[ai][bj][mh + m][0], v1 = xv[m][bj][1] + acc[ai][bj][mh + m][1];
                    if (WH) { *(f32x4*)(H + row * 1024 + c) = v0; *(f32x4*)(H + row * 1024 + c + 4) = v1; }
                    *(u32x4*)(HB + row * 1024 + c) = pack8(v0, v1);
                    s += (v0[0] * v0[0] + v0[1] * v0[1]) + (v0[2] * v0[2] + v0[3] * v0[3]) + (v1[0] * v1[0] + v1[1] * v1[1]) + (v1[2] * v1[2] + v1[3] * v1[3]); }
                s += __shfl_xor(s, 16); s += __shfl_xor(s, 32);
                if (fq == 0) __hip_atomic_fetch_add(SS + row, s, __ATOMIC_RELAXED, __HIP_MEMORY_SCOPE_AGENT); }
            asm volatile("" ::: "memory");
          }
    }
    __device__ __forceinline__ void operator()(const f32x4 (&acc)[2][2][4][2], const Unit& u, int wr, int wc, int fr, int fq) const {
        if (wH) body<true>(acc, u, wr, wc, fr, fq); else body<false>(acc, u, wr, wc, fr, fq);
    }
};
struct EpiUp {
    static constexpr bool PERM = true, AFTER_DRAIN = false, MIDK = false;
    const float* SS; bf16_t* U;
    __device__ __forceinline__ void operator()(const f32x4 (&acc)[2][2][4][2], const Unit& u, int wr, int wc, int fr, int fq) const {
        const int row0 = u.pm * BM + wr * 64 + fr, col0 = u.pn * BM + wc * 32 + 8 * fq;
        float ssv[2][4];
#pragma unroll
        for (int ai = 0; ai < 2; ++ai)
#pragma unroll
            for (int m = 0; m < 4; ++m) ssv[ai][m] = SS[row0 + ai * HALF + m * 16];
#pragma unroll
        for (int ai = 0; ai < 2; ++ai)
#pragma unroll
            for (int m = 0; m < 4; ++m) { const size_t row = (size_t)(row0 + ai * HALF + m * 16);
                const float rs = __builtin_amdgcn_rsqf(ssv[ai][m] * (1.0f / 1024.0f) + 1e-6f);
#pragma unroll
                for (int bj = 0; bj < 2; ++bj) { f32x4 v0 = acc[ai][bj][m][0] * rs, v1 = acc[ai][bj][m][1] * rs;
#pragma unroll
                    for (int j = 0; j < 4; ++j) { const float a = fmaxf(v0[j], 0.f), b = fmaxf(v1[j], 0.f); v0[j] = a * a; v1[j] = b * b; }
                    *(u32x4*)(U + row * 4096 + col0 + bj * HALF) = pack8(v0, v1); } }
    }
};
struct EpiDown {
    static constexpr bool PERM = false, AFTER_DRAIN = false, MIDK = false;
    float* H; float* SS;
    __device__ __forceinline__ void operator()(const f32x4 (&acc)[2][2][4][2], const Unit& u, int wr, int wc, int fr, int fq) const {
        const int row0 = u.pm * BM + wr * 64 + fr, col0 = u.pn * BM + wc * 32 + 4 * fq;
#pragma unroll
        for (int ai = 0; ai < 2; ++ai)
#pragma unroll
            for (int m = 0; m < 4; ++m) { const size_t row = (size_t)(row0 + ai * HALF + m * 16); float s = 0.f;
#pragma unroll
                for (int bj = 0; bj < 2; ++bj)
#pragma unroll
                    for (int n = 0; n < 2; ++n) { float* p = H + row * 1024 + col0 + bj * HALF + n * 16; const f32x4 v = *(const f32x4*)p + acc[ai][bj][m][n]; *(f32x4*)p = v;
                        s += (v[0] * v[0] + v[1] * v[1]) + (v[2] * v[2] + v[3] * v[3]); }
                s += __shfl_xor(s, 16); s += __shfl_xor(s, 32);
                if (fq == 0) __hip_atomic_fetch_add(SS + row, s, __ATOMIC_RELAXED, __HIP_MEMORY_SCOPE_AGENT); }
    }
};

struct EpiDownNorm {
    static constexpr bool PERM = true, AFTER_DRAIN = true, MIDK = false;
    const bf16_t* HB; float* OUT; float* SS; unsigned* CNT; const float* g;
    __device__ __forceinline__ void fused(f32x4 (&acc)[2][2][4][2], const Unit& u, int wr, int wc, int fr, int fq, PG8_LAS unsigned char* lds, int wid, int lane) const {
        const int row0 = u.pm * BM + wr * 64 + fr, col0 = u.pn * BM + wc * 32 + 8 * fq;
        u32x4 hbv[2][4][2];
#pragma unroll
        for (int ai = 0; ai < 2; ++ai)
#pragma unroll
            for (int m = 0; m < 4; ++m)
#pragma unroll
                for (int bj = 0; bj < 2; ++bj) hbv[ai][m][bj] = *(const u32x4*)(HB + (size_t)(row0 + ai * HALF + m * 16) * 1024 + col0 + bj * HALF);
        float old8[2][4];
#pragma unroll
        for (int ai = 0; ai < 2; ++ai)
#pragma unroll
            for (int m = 0; m < 4; ++m) { const size_t row = (size_t)(row0 + ai * HALF + m * 16); float s = 0.f;
#pragma unroll
                for (int bj = 0; bj < 2; ++bj) { const u32x4 hb = hbv[ai][m][bj];
                    const f32x4 v0 = (f32x4){bf_lo(hb.x), bf_hi(hb.x), bf_lo(hb.y), bf_hi(hb.y)} + acc[ai][bj][m][0], v1 = (f32x4){bf_lo(hb.z), bf_hi(hb.z), bf_lo(hb.w), bf_hi(hb.w)} + acc[ai][bj][m][1];
                    acc[ai][bj][m][0] = v0; acc[ai][bj][m][1] = v1;
                    s += (v0[0] * v0[0] + v0[1] * v0[1]) + (v0[2] * v0[2] + v0[3] * v0[3]) + (v1[0] * v1[0] + v1[1] * v1[1]) + (v1[2] * v1[2] + v1[3] * v1[3]); }
                s += __shfl_xor(s, 16); s += __shfl_xor(s, 32);
                old8[ai][m] = (fq == 0) ? __hip_atomic_fetch_add(SS + row, s, __ATOMIC_RELAXED, __HIP_MEMORY_SCOPE_AGENT) : 0.f; }
        asm volatile("s_waitcnt vmcnt(0)" :: "v"(old8[0][0]), "v"(old8[0][1]), "v"(old8[0][2]), "v"(old8[0][3]), "v"(old8[1][0]), "v"(old8[1][1]), "v"(old8[1][2]), "v"(old8[1][3]) : "memory");
        __syncthreads();
        if (threadIdx.x == 0) {
            unsigned* c = CNT + 64 * u.pm;
            __hip_atomic_fetch_add(c, 1u, __ATOMIC_RELAXED, __HIP_MEMORY_SCOPE_AGENT);
            unsigned sp = 0u;
            while (__hip_atomic_load(c, __ATOMIC_RELAXED, __HIP_MEMORY_SCOPE_AGENT) < 4u) { __builtin_amdgcn_s_sleep(1); if (++sp > (1u << 22)) break; }
            __builtin_amdgcn_fence(__ATOMIC_ACQUIRE, "agent");
            asm volatile("s_waitcnt vmcnt(0)" ::: "memory");
        }
        __syncthreads();
        f32x4 gv[2][2]; float ssv[2][4];
#pragma unroll
        for (int bj = 0; bj < 2; ++bj)
#pragma unroll
            for (int n = 0; n < 2; ++n) gv[bj][n] = *(const f32x4*)(g + col0 + bj * HALF + 4 * n);
#pragma unroll
        for (int ai = 0; ai < 2; ++ai)
#pragma unroll
            for (int m = 0; m < 4; ++m) ssv[ai][m] = __hip_atomic_load(SS + (size_t)(row0 + ai * HALF + m * 16), __ATOMIC_RELAXED, __HIP_MEMORY_SCOPE_AGENT);
#pragma unroll
        for (int ai = 0; ai < 2; ++ai)
#pragma unroll
            for (int m = 0; m < 4; ++m) { const size_t row = (size_t)(row0 + ai * HALF + m * 16);
                const float rs = __builtin_amdgcn_rsqf(ssv[ai][m] * (1.0f / 1024.0f) + 1e-6f);
#pragma unroll
                for (int bj = 0; bj < 2; ++bj)
#pragma unroll
                    for (int n = 0; n < 2; ++n) *(f32x4*)(OUT + row * 1024 + col0 + bj * HALF + 4 * n) = acc[ai][bj][m][n] * rs * gv[bj][n]; }
    }
};
template <class Epi, class Sched, bool ALIGN_EPI = false, bool SP2 = false>
__device__ __forceinline__ void gemm_phase(PG8_LAS unsigned char* lds, const Gemm g, const Sched& S, const Epi& E) {
    int tid_ = threadIdx.x; asm volatile("" : "+v"(tid_));
    const int tid = tid_, wid = __builtin_amdgcn_readfirstlane(tid >> 6), lane = tid & 63, wr = wid >> 2, wc = wid & 3, fr = lane & 15, fq = lane >> 4;
    const int K = g.K, nt = K / BK;
    unsigned voffA[2], voffB[2];
#pragma unroll
    for (int i = 0; i < 2; ++i) { int R, C; stage_rc(tid * 16 + i * 8192, R, C); const int Rb = Epi::PERM ? ((R & ~31) + perm32(R & 31)) : R;
        voffA[i] = (unsigned)(R * K + C) * 2u; voffB[i] = (unsigned)(Rb * K + C) * 2u; }
    const size_t kstep = (size_t)(BK * 2);
    const size_t hstep = (size_t)HALF * K * 2;
    const size_t tstep = 2 * hstep;
    const unsigned ldsw = (unsigned)wid * 1024u;
    const int aoff = lds_byte(wr * 64 + fr, fq * 8), boff = lds_byte(wc * 32 + fr, fq * 8);
#define PG8_SA(b, h) (((b) * 2 + (h)) * HTB)
#define PG8_SB(b, h) ((4 + (b) * 2 + (h)) * HTB)
#define PG8_STAGE(bufoff, gbase, voff) do { _Pragma("unroll") for (int _i = 0; _i < 2; ++_i) \
        __builtin_amdgcn_global_load_lds((const unsigned*)((const char*)(gbase) + (voff)[_i]), (PG8_LAS unsigned*)(lds + (bufoff) + ldsw + _i * 8192), 16, 0, 0); } while (0)
#define PG8_LDA(dst, b, h) do { _Pragma("unroll") for (int m = 0; m < 4; ++m) _Pragma("unroll") for (int k = 0; k < 2; ++k) dst[m][k] = *(const PG8_LAS bf16x8*)(lds + PG8_SA(b, h) + aoff + m * 2048 + k * 1024); } while (0)
#define PG8_LDB(dst, b, h) do { _Pragma("unroll") for (int n = 0; n < 2; ++n) _Pragma("unroll") for (int k = 0; k < 2; ++k) dst[n][k] = *(const PG8_LAS bf16x8*)(lds + PG8_SB(b, h) + boff + n * 2048 + k * 1024); } while (0)
#define PG8_MMA(ai, bj, At, Bt) do { __builtin_amdgcn_s_setprio(1); _Pragma("unroll") for (int m = 0; m < 4; ++m) _Pragma("unroll") for (int n = 0; n < 2; ++n) _Pragma("unroll") for (int k = 0; k < 2; ++k) \
        acc[ai][bj][m][n] = __builtin_amdgcn_mfma_f32_16x16x32_bf16(Bt[n][k], At[m][k], acc[ai][bj][m][n], 0, 0, 0); __builtin_amdgcn_s_setprio(0); } while (0)
#define PG8_WAIT_V(n) asm volatile("s_waitcnt vmcnt(" #n ")" ::: "memory")
#define PG8_WAIT_L(n) asm volatile("s_waitcnt lgkmcnt(" #n ")" ::: "memory")
#define PG8_BAR __builtin_amdgcn_s_barrier()
#define PG8_SCHED __builtin_amdgcn_sched_barrier(0)
    Unit cur, nxt; int ui = 0;
    if (!S.next(0, cur)) return;
    f32x4 acc[2][2][4][2];
#pragma unroll
    for (int a = 0; a < 2; ++a)
#pragma unroll
        for (int b = 0; b < 2; ++b)
#pragma unroll
            for (int m = 0; m < 4; ++m)
#pragma unroll
                for (int n = 0; n < 2; ++n) acc[a][b][m][n] = (f32x4){0.f, 0.f, 0.f, 0.f};
    bf16x8 At[4][2], B0[2][2], B1[2][2];
    const char* cA = (const char*)g.A + (size_t)cur.pm * tstep; const char* cB = (const char*)g.Bt + (size_t)cur.pn * tstep;
    S.a_ready(cur);
    if constexpr (SP2) {
        PG8_STAGE(PG8_SB(0, 0), cB, voffB); PG8_STAGE(PG8_SB(0, 1), cB + hstep, voffB); PG8_STAGE(PG8_SA(0, 0), cA, voffA); PG8_STAGE(PG8_SA(0, 1), cA + hstep, voffA);
        if (wr == 1) PG8_BAR;
        PG8_WAIT_V(2); PG8_BAR;
        PG8_STAGE(PG8_SB(1, 0), cB + kstep, voffB); PG8_STAGE(PG8_SA(1, 0), cA + kstep, voffA); PG8_STAGE(PG8_SB(1, 1), cB + hstep + kstep, voffB);
        PG8_WAIT_V(6); PG8_BAR;
    } else {
        PG8_STAGE(PG8_SB(0, 0), cB, voffB); PG8_STAGE(PG8_SA(0, 0), cA, voffA); PG8_STAGE(PG8_SB(0, 1), cB + hstep, voffB); PG8_STAGE(PG8_SA(0, 1), cA + hstep, voffA);
        if (wr == 1) PG8_BAR;
        PG8_WAIT_V(4); PG8_BAR;
        PG8_STAGE(PG8_SB(1, 0), cB + kstep, voffB); PG8_STAGE(PG8_SA(1, 0), cA + kstep, voffA); PG8_STAGE(PG8_SB(1, 1), cB + hstep + kstep, voffB);
        PG8_WAIT_V(6); PG8_BAR;
    }
    for (;;) {
        const bool has_next = S.next(ui + 1, nxt);
        const char* nA = has_next ? (const char*)g.A + (size_t)nxt.pm * tstep : cA; const char* nB = has_next ? (const char*)g.Bt + (size_t)nxt.pn * tstep : cB;
        for (int t = 0; t < nt; t += 2) {
            const bool last = (t == nt - 2);
            const char* a1 = cA + (size_t)(t + 1) * kstep;
            const char* a2 = last ? nA : cA + (size_t)(t + 2) * kstep; const char* b2 = last ? nB : cB + (size_t)(t + 2) * kstep;
            const char* a3 = a2 + kstep; const char* b3 = b2 + kstep;
            if (last && has_next) S.a_ready(nxt);
            if constexpr (Epi::MIDK) { if (t == (nt >> 1)) E.mid(acc, cur, wr, wc, fr, fq); }
            if constexpr (SP2) {
            PG8_LDB(B0, 0, 0); PG8_LDB(B1, 0, 1); PG8_SCHED; PG8_LDA(At, 0, 0); PG8_STAGE(PG8_SA(1, 1), a1 + hstep, voffA);
            PG8_WAIT_V(8); PG8_WAIT_L(0); PG8_BAR; PG8_MMA(0, 0, At, B0); PG8_MMA(0, 1, At, B1); PG8_BAR; PG8_SCHED;
            PG8_LDA(At, 0, 1); PG8_STAGE(PG8_SB(0, 0), b2, voffB); PG8_STAGE(PG8_SB(0, 1), b2 + hstep, voffB); PG8_STAGE(PG8_SA(0, 0), a2, voffA);
            PG8_WAIT_V(8); PG8_WAIT_L(0); PG8_BAR; PG8_MMA(1, 0, At, B0); PG8_MMA(1, 1, At, B1); PG8_BAR; PG8_SCHED;
            PG8_LDB(B0, 1, 0); PG8_LDB(B1, 1, 1); PG8_SCHED; PG8_LDA(At, 1, 0); PG8_STAGE(PG8_SA(0, 1), a2 + hstep, voffA);
            PG8_WAIT_V(8); PG8_WAIT_L(0); PG8_BAR; PG8_MMA(0, 0, At, B0); PG8_MMA(0, 1, At, B1); PG8_BAR; PG8_SCHED;
            PG8_LDA(At, 1, 1); PG8_STAGE(PG8_SB(1, 0), b3, voffB); PG8_STAGE(PG8_SB(1, 1), b3 + hstep, voffB); PG8_STAGE(PG8_SA(1, 0), a3, voffA);
            PG8_WAIT_V(8); PG8_WAIT_L(0); PG8_BAR; PG8_MMA(1, 0, At, B0); PG8_MMA(1, 1, At, B1); PG8_BAR; PG8_SCHED;
            } else {
            PG8_LDB(B0, 0, 0); PG8_SCHED; PG8_LDA(At, 0, 0); PG8_STAGE(PG8_SA(1, 1), a1 + hstep, voffA);
            PG8_WAIT_L(8); PG8_BAR; PG8_WAIT_L(0); PG8_MMA(0, 0, At, B0); PG8_BAR; PG8_SCHED;
            PG8_LDB(B1, 0, 1); PG8_STAGE(PG8_SB(0, 0), b2, voffB);
            PG8_BAR; PG8_WAIT_L(0); PG8_MMA(0, 1, At, B1); PG8_BAR;
            PG8_LDA(At, 0, 1); PG8_STAGE(PG8_SA(0, 0), a2, voffA);
            PG8_BAR; PG8_WAIT_L(0); PG8_MMA(1, 0, At, B0); PG8_BAR; PG8_SCHED;
            PG8_STAGE(PG8_SB(0, 1), b2 + hstep, voffB);
            PG8_WAIT_V(6); PG8_BAR; PG8_MMA(1, 1, At, B1); PG8_BAR;
            PG8_LDB(B0, 1, 0); PG8_SCHED; PG8_LDA(At, 1, 0); PG8_STAGE(PG8_SA(0, 1), a2 + hstep, voffA);
            PG8_WAIT_L(8); PG8_BAR; PG8_WAIT_L(0); PG8_MMA(0, 0, At, B0); PG8_BAR; PG8_SCHED;
            PG8_LDB(B1, 1, 1); PG8_STAGE(PG8_SB(1, 0), b3, voffB);
            PG8_BAR; PG8_WAIT_L(0); PG8_MMA(0, 1, At, B1); PG8_BAR;
            PG8_LDA(At, 1, 1); PG8_STAGE(PG8_SA(1, 0), a3, voffA);
            PG8_BAR; PG8_WAIT_L(0); PG8_MMA(1, 0, At, B0); PG8_BAR; PG8_SCHED;
            PG8_STAGE(PG8_SB(1, 1), b3 + hstep, voffB);
            PG8_WAIT_V(6); PG8_BAR; PG8_MMA(1, 1, At, B1); PG8_BAR;
            }
        }
        if constexpr (ALIGN_EPI) { if (wr == 0) PG8_BAR; }
        if constexpr (!Epi::AFTER_DRAIN) { E(acc, cur, wr, wc, fr, fq); S.done(cur); }
        if (!has_next) break;
#pragma unroll
        for (int a = 0; a < 2; ++a)
#pragma unroll
            for (int b = 0; b < 2; ++b)
#pragma unroll
                for (int m = 0; m < 4; ++m)
#pragma unroll
                    for (int n = 0; n < 2; ++n) acc[a][b][m][n] = (f32x4){0.f, 0.f, 0.f, 0.f};
        cur = nxt; cA = nA; cB = nB; ++ui;
        if constexpr (ALIGN_EPI) { if (wr == 1) PG8_BAR; }
    }
    PG8_WAIT_V(0);
    if constexpr (!ALIGN_EPI) { if (wr == 0) PG8_BAR; }
    PG8_BAR;
    if constexpr (Epi::AFTER_DRAIN) { E.fused(acc, cur, wr, wc, fr, fq, lds, wid, lane); S.done(cur); }
#undef PG8_SA
#undef PG8_SB
#undef PG8_STAGE
#undef PG8_LDA
#undef PG8_LDB
#undef PG8_MMA
#undef PG8_WAIT_V
#undef PG8_WAIT_L
#undef PG8_BAR
#undef PG8_SCHED
}
}
using pg8::bf16_t; using pg8::bf16x8; using pg8::f32x4; using pg8::u32x4; using pg8::cvt_pk_bf16; using pg8::bf_lo; using pg8::bf_hi; using pg8::pack8; using pg8::sigmoid_f;
constexpr int SEQ = 4096, NB = 4, DM = 1024, MTOK = NB * SEQ, DIN = 6144, DFF = 4096, NCHUNK = 32;
constexpr size_t MiB = 1u << 20;
constexpr size_t WS_WIN = 0, WS_WOA = 12 * MiB, WS_WOB = 14 * MiB, WS_WOUT = 16 * MiB, WS_WUP = 18 * MiB, WS_WDN = 26 * MiB, WS_WG = 34 * MiB, WS_WSM = 35 * MiB;
constexpr size_t WS_SUMA = 35 * MiB + 512 * 1024, WS_SUMB = 36 * MiB, WS_LNST = 36 * MiB + 512 * 1024, WS_SS1 = WS_LNST + 128 * 1024, WS_SS2 = WS_SS1 + 64 * 1024;
constexpr size_t WS_Z4 = 38 * MiB;
constexpr size_t WS_TMP = WS_Z4, WS_MRG = WS_Z4 + 64 * MiB, WS_U = WS_Z4;
constexpr size_t WS_XN = 166 * MiB;
constexpr size_t WS_YA = WS_XN, WS_H1B = WS_XN, WS_YB = 198 * MiB, WS_END = 230 * MiB;
constexpr size_t WS_BAR = 37 * MiB;
constexpr int LDS_BYTES = 144 * 1024;

struct Params { const float* in[21]; float* out; unsigned char* ws; };

typedef float f32x2 __attribute__((ext_vector_type(2)));
__device__ __forceinline__ float wave_sum(float v) {
#pragma unroll
    for (int o = 1; o < 64; o <<= 1) v += __shfl_xor(v, o);
    return v;
}
__device__ __forceinline__ void tr_item(const float* __restrict__ W, int N, int K, bf16_t* __restrict__ WT, const float* __restrict__ ks, float* scr, int item, int lane, int ldk = 0) {
    if (ldk == 0) ldk = K;
    const int nblk = N / 32, kb = item / nblk, nb = item % nblk, k0 = 64 * kb, n0 = 32 * nb;
#pragma unroll 8
    for (int i = 0; i < 32; ++i) { const int kk = 2 * i + (lane >> 5); scr[kk * 33 + (lane & 31)] = W[(size_t)(k0 + kk) * N + n0 + (lane & 31)]; }
    asm volatile("s_waitcnt lgkmcnt(0)" ::: "memory");
    const int c = lane & 7;
    f32x4 s0 = {1.f, 1.f, 1.f, 1.f}, s1 = {1.f, 1.f, 1.f, 1.f};
    if (ks) { s0 = *(const f32x4*)(ks + k0 + 8 * c); s1 = *(const f32x4*)(ks + k0 + 8 * c + 4); }
#pragma unroll
    for (int j = 0; j < 4; ++j) { const int n = (lane >> 3) + 8 * j; const float* s = scr + (8 * c) * 33 + n;
        u32x4 o; o.x = cvt_pk_bf16(s[0 * 33] * s0[0], s[1 * 33] * s0[1]); o.y = cvt_pk_bf16(s[2 * 33] * s0[2], s[3 * 33] * s0[3]); o.z = cvt_pk_bf16(s[4 * 33] * s1[0], s[5 * 33] * s1[1]); o.w = cvt_pk_bf16(s[6 * 33] * s1[2], s[7 * 33] * s1[3]);
        *(u32x4*)(WT + (size_t)(n0 + n) * ldk + k0 + 8 * c) = o; }
    asm volatile("s_waitcnt lgkmcnt(0)" ::: "memory");
}
__device__ __forceinline__ void rms_row_to_bf16(const float* __restrict__ xrow, const float* __restrict__ g, bf16_t* __restrict__ orow, int lane) {
    const f32x4* xr = (const f32x4*)xrow + lane; const f32x4* gr = (const f32x4*)g + lane;
    f32x4 v[4]; float s = 0.f;
#pragma unroll
    for (int j = 0; j < 4; ++j) { v[j] = xr[64 * j]; s += (v[j][0] * v[j][0] + v[j][1] * v[j][1]) + (v[j][2] * v[j][2] + v[j][3] * v[j][3]); }
    const float rs = 1.0f / sqrtf(wave_sum(s) * (1.0f / 1024.0f) + 1e-6f);
    unsigned long long* o8 = (unsigned long long*)orow + lane;
#pragma unroll
    for (int j = 0; j < 4; ++j) { const f32x4 gg = gr[64 * j]; const f32x4 y = v[j] * rs * gg;
        o8[64 * j] = (unsigned long long)cvt_pk_bf16(y[0], y[1]) | ((unsigned long long)cvt_pk_bf16(y[2], y[3]) << 32); }
}
__device__ __forceinline__ void rms_rows2_to_bf16(const float* __restrict__ xa, const float* __restrict__ xb, const float* __restrict__ g, bf16_t* __restrict__ oa, bf16_t* __restrict__ ob, int lane) {
    const f32x4* ra = (const f32x4*)xa + lane; const f32x4* rb = (const f32x4*)xb + lane; const f32x4* gr = (const f32x4*)g + lane;
    f32x4 va[4], vb[4], gg[4]; float sa = 0.f, sb = 0.f;
#pragma unroll
    for (int j = 0; j < 4; ++j) { va[j] = ra[64 * j]; vb[j] = rb[64 * j]; gg[j] = gr[64 * j]; }
#pragma unroll
    for (int j = 0; j < 4; ++j) { sa += (va[j][0] * va[j][0] + va[j][1] * va[j][1]) + (va[j][2] * va[j][2] + va[j][3] * va[j][3]); sb += (vb[j][0] * vb[j][0] + vb[j][1] * vb[j][1]) + (vb[j][2] * vb[j][2] + vb[j][3] * vb[j][3]); }
#pragma unroll
    for (int o = 1; o < 64; o <<= 1) { sa += __shfl_xor(sa, o); sb += __shfl_xor(sb, o); }
    const float rsa = 1.0f / sqrtf(sa * (1.0f / 1024.0f) + 1e-6f), rsb = 1.0f / sqrtf(sb * (1.0f / 1024.0f) + 1e-6f);
    unsigned long long* pa = (unsigned long long*)oa + lane; unsigned long long* pb = (unsigned long long*)ob + lane;
#pragma unroll
    for (int j = 0; j < 4; ++j) { const f32x4 ya = va[j] * rsa * gg[j], yb = vb[j] * rsb * gg[j];
        pa[64 * j] = (unsigned long long)cvt_pk_bf16(ya[0], ya[1]) | ((unsigned long long)cvt_pk_bf16(ya[2], ya[3]) << 32);
        pb[64 * j] = (unsigned long long)cvt_pk_bf16(yb[0], yb[1]) | ((unsigned long long)cvt_pk_bf16(yb[2], yb[3]) << 32); }
}
__device__ __forceinline__ void unpack8(const u32x4 w, float (&f)[8]) { f[0] = bf_lo(w.x); f[1] = bf_hi(w.x); f[2] = bf_lo(w.y); f[3] = bf_hi(w.y); f[4] = bf_lo(w.z); f[5] = bf_hi(w.z); f[6] = bf_lo(w.w); f[7] = bf_hi(w.w); }
__device__ __forceinline__ float bf16_to_f(bf16_t h) { return __uint_as_float(((unsigned)h) << 16); }
__device__ __forceinline__ bf16_t f_to_bf16(float f) { return (bf16_t)(cvt_pk_bf16(f, 0.f) & 0xffffu); }

struct Ctx {
    const float* in[21]; float* out; unsigned char* ws;
    bf16_t *WIN, *WOA, *WOB, *WOUT, *WUP, *WDN, *WG, *WSM, *Z4, *ZG, *XN, *YA, *YB, *MRG, *H1B, *U;
    float *SUMA, *SUMB, *LNST, *SS1, *SS2, *TMP; unsigned* MASK;
};

constexpr int XC_LD = 264;
__device__ __forceinline__ void mixer_a_tile(unsigned char* lds, const Ctx& C, int tile) {
    int tid_ = threadIdx.x; asm volatile("" : "+v"(tid_));
    const int tid = tid_, lane = tid & 63, wave = tid >> 6, fr = lane & 15, fq = lane >> 4;
    const int h = tile & 3, ck = (tile >> 2) & 31, b = tile >> 7;
    const size_t row_base = (size_t)b * SEQ + (size_t)ck * 128;
    bf16_t* XC = (bf16_t*)lds;
    bf16_t* HB = (bf16_t*)(lds + 67584);
    float* H0 = (float*)(lds + 135168);
    const bf16_t* wgr = C.WG + ((size_t)(h * 2 + 0) * 256 + 32 * wave + fr) * 256 + 8 * fq;
    bf16x8 gf[4][4];
#pragma unroll
    for (int k = 0; k < 3; ++k) { gf[k][0] = *(const bf16x8*)(wgr + k * 32); gf[k][1] = *(const bf16x8*)(wgr + 4096 + k * 32); gf[k][2] = *(const bf16x8*)(wgr + 65536 + k * 32); gf[k][3] = *(const bf16x8*)(wgr + 65536 + 4096 + k * 32); }
    {
        const int cc = tid & 31, tg = tid >> 5, ch0 = h * 256 + cc * 8;
        const float* cw = C.in[3]; const float* cbp = C.in[4];
        float w[4][8], cb[8];
#pragma unroll
        for (int k = 0; k < 4; ++k) { const f32x4 w0 = *(const f32x4*)(cw + k * DM + ch0), w1 = *(const f32x4*)(cw + k * DM + ch0 + 4);
#pragma unroll
            for (int j = 0; j < 4; ++j) { w[k][j] = w0[j]; w[k][4 + j] = w1[j]; } }
        { const f32x4 b0 = *(const f32x4*)(cbp + ch0), b1 = *(const f32x4*)(cbp + ch0 + 4);
#pragma unroll
          for (int j = 0; j < 4; ++j) { cb[j] = b0[j]; cb[4 + j] = b1[j]; } }
        u32x4 xr[11];
#pragma unroll
        for (int tt = 0; tt < 11; ++tt) { const int tl = tg * 8 - 3 + tt; const int tglob = ck * 128 + tl;
            xr[tt] = (tglob >= 0) ? *(const u32x4*)(C.Z4 + ((size_t)b * SEQ + tglob) * 4096 + ch0) : (u32x4){0u, 0u, 0u, 0u}; }
#pragma unroll
        for (int t = 0; t < 8; ++t) { float o[8];
#pragma unroll
            for (int j = 0; j < 8; ++j) o[j] = cb[j];
#pragma unroll
            for (int k = 0; k < 4; ++k) { float x[8]; unpack8(xr[t + 3 - k], x);
#pragma unroll
                for (int j = 0; j < 8; ++j) o[j] += w[k][j] * x[j]; }
            u32x4 pk; pk.x = cvt_pk_bf16(o[0], o[1]); pk.y = cvt_pk_bf16(o[2], o[3]); pk.z = cvt_pk_bf16(o[4], o[5]); pk.w = cvt_pk_bf16(o[6], o[7]);
            *(u32x4*)(XC + (tg * 8 + t) * XC_LD + cc * 8) = pk; }
    }
    __syncthreads();
    if (wave >= 4) __builtin_amdgcn_s_sleep(48);
    f32x4 accr[2][8], acci[2][8];
#pragma unroll
    for (int n = 0; n < 2; ++n)
#pragma unroll
        for (int m = 0; m < 8; ++m) { accr[n][m] = (f32x4){0.f, 0.f, 0.f, 0.f}; acci[n][m] = (f32x4){0.f, 0.f, 0.f, 0.f}; }
    {
        const bf16_t* xa = XC + fr * XC_LD + 8 * fq;
#pragma unroll
        for (int ks = 0; ks < 8; ++ks) {
            if (ks + 3 < 8) { const bf16_t* wn = wgr + (ks + 3) * 32; bf16x8* d = gf[(ks + 3) % 4];
                d[0] = *(const bf16x8*)(wn); d[1] = *(const bf16x8*)(wn + 4096); d[2] = *(const bf16x8*)(wn + 65536); d[3] = *(const bf16x8*)(wn + 65536 + 4096); }
            const bf16x8* cf = gf[ks % 4];
#pragma unroll
            for (int m = 0; m < 8; ++m) { const bf16x8 a = *(const bf16x8*)(xa + m * 16 * XC_LD + ks * 32);
                accr[0][m] = __builtin_amdgcn_mfma_f32_16x16x32_bf16(a, cf[0], accr[0][m], 0, 0, 0);
                accr[1][m] = __builtin_amdgcn_mfma_f32_16x16x32_bf16(a, cf[1], accr[1][m], 0, 0, 0);
                acci[0][m] = __builtin_amdgcn_mfma_f32_16x16x32_bf16(a, cf[2], acci[0][m], 0, 0, 0);
                acci[1][m] = __builtin_amdgcn_mfma_f32_16x16x32_bf16(a, cf[3], acci[1][m], 0, 0, 0); }
            asm volatile("" ::: "memory");
        }
    }
#pragma unroll
    for (int n = 0; n < 2; ++n) {
        const int chl = 32 * wave + 16 * n + fr, ch = h * 256 + chl;
        const float brv = C.in[6][ch], biv = C.in[8][ch], lam = C.in[9][ch];
        const float sp8 = -8.0f * (fmaxf(-lam, 0.f) + log1pf(__expf(-fabsf(lam))));
        const float sp8l2 = sp8 * 1.4426950409f, sp16 = 2.0f * sp8; const float nbr = -1.4426950409f * brv, nbi = -1.4426950409f * biv;
        float hc = 0.f, Ac = 1.f;
#pragma unroll
        for (int m = 0; m < 8; ++m) {
            float a[4], bx[4];
#pragma unroll
            for (int hh = 0; hh < 2; ++hh) {
                const int t = 16 * m + 4 * fq + 2 * hh;
                const f32x2 xcv = {bf16_to_f(XC[t * XC_LD + chl]), bf16_to_f(XC[(t + 1) * XC_LD + chl])};
                const f32x2 pr = {accr[n][m][2 * hh], accr[n][m][2 * hh + 1]}, pi = {acci[n][m][2 * hh], acci[n][m][2 * hh + 1]};
                f32x2 xr = pr * (-1.4426950409f) + nbr, xi = pi * (-1.4426950409f) + nbi;
                xr.x = fminf(xr.x, 60.f); xr.y = fminf(xr.y, 60.f); xi.x = fminf(xi.x, 60.f); xi.y = fminf(xi.y, 60.f);
                f32x2 er, ei; er.x = __builtin_amdgcn_exp2f(xr.x); er.y = __builtin_amdgcn_exp2f(xr.y); ei.x = __builtin_amdgcn_exp2f(xi.x); ei.y = __builtin_amdgcn_exp2f(xi.y);
                const f32x2 dr = er + 1.0f, di = ei + 1.0f, dd = dr * di;
                f32x2 inv; inv.x = __builtin_amdgcn_rcpf(dd.x); inv.y = __builtin_amdgcn_rcpf(dd.y);
                const f32x2 r = di * inv, ig = dr * inv;
                const f32x2 l2 = r * sp8l2;
                f32x2 av; av.x = __builtin_amdgcn_exp2f(l2.x); av.y = __builtin_amdgcn_exp2f(l2.y);
                const f32x2 x2 = r * sp16;
                f32x2 q = x2 * 0.0013888889f + 0.0083333338f; q = q * x2 + 0.041666668f; q = q * x2 + 0.16666667f; q = q * x2 + 0.5f; q = q * x2 + 1.0f;
                const f32x2 ser = -x2 * q, dir = 1.0f - av * av;
                f32x2 m2; m2.x = fmaxf((x2.x > -0.25f) ? ser.x : dir.x, 0.f); m2.y = fmaxf((x2.y > -0.25f) ? ser.y : dir.y, 0.f);
                f32x2 mu; mu.x = __builtin_amdgcn_sqrtf(m2.x); mu.y = __builtin_amdgcn_sqrtf(m2.y);
                const f32x2 bxx = xcv * ig * mu;
                a[2 * hh] = av.x; a[2 * hh + 1] = av.y; bx[2 * hh] = bxx.x; bx[2 * hh + 1] = bxx.y;
            }
            const float p0 = a[0], h0l = bx[0];
            const float p1 = p0 * a[1], h1l = h0l * a[1] + bx[1];
            const float p2 = p1 * a[2], h2l = h1l * a[2] + bx[2];
            const float p3 = p2 * a[3], h3l = h2l * a[3] + bx[3];
            float Ai = p3, Bi = h3l;
            float At = __shfl_up(Ai, 16), Bt = __shfl_up(Bi, 16);
            if (fq >= 1) { Bi = Bt * Ai + Bi; Ai = At * Ai; }
            At = __shfl_up(Ai, 32); Bt = __shfl_up(Bi, 32);
            if (fq >= 2) { Bi = Bt * Ai + Bi; Ai = At * Ai; }
            const float Am = __shfl(Ai, 48 + fr), Bm = __shfl(Bi, 48 + fr);
            float Ae = __shfl_up(Ai, 16), Be = __shfl_up(Bi, 16);
            if (fq == 0) { Ae = 1.f; Be = 0.f; }
            const float hin = Be + Ae * hc, Pin = Ae * Ac;
            accr[n][m] = (f32x4){Pin * p0, Pin * p1, Pin * p2, Pin * p3};
            acci[n][m] = (f32x4){h0l + p0 * hin, h1l + p1 * hin, h2l + p2 * hin, h3l + p3 * hin};
            hc = hc * Am + Bm; Ac *= Am;
        }
        if (fq == 0) { const size_t o = ((size_t)(b * NCHUNK + ck)) * DM + ch;
            __hip_atomic_store(C.SUMA + o, Ac, __ATOMIC_RELAXED, __HIP_MEMORY_SCOPE_AGENT); __hip_atomic_store(C.SUMB + o, hc, __ATOMIC_RELAXED, __HIP_MEMORY_SCOPE_AGENT); }
    }
    asm volatile("s_waitcnt vmcnt(0)" ::: "memory");
    __syncthreads();
    if (tid == 0) {
        unsigned* mk = C.MASK + 64 * (b * 4 + h);
        __hip_atomic_fetch_or(mk, 1u << ck, __ATOMIC_RELAXED, __HIP_MEMORY_SCOPE_AGENT);
        const unsigned need = (1u << ck) - 1u; unsigned sp = 0u;
        while ((__hip_atomic_load(mk, __ATOMIC_RELAXED, __HIP_MEMORY_SCOPE_AGENT) & need) != need) { __builtin_amdgcn_s_sleep(1); if (++sp > (1u << 22)) break; }
        __builtin_amdgcn_fence(__ATOMIC_ACQUIRE, "agent");
        asm volatile("s_waitcnt vmcnt(0)" ::: "memory");
    }
    __syncthreads();
    if (tid < 256) {
        const int ch = h * 256 + tid; float hcar = 0.f;
        for (int c2 = 0; c2 < ck; c2 += 8) { float a[8], bb[8];
#pragma unroll
            for (int j = 0; j < 8; ++j) { const bool ok = (c2 + j) < ck; const size_t o = ((size_t)(b * NCHUNK + (ok ? c2 + j : 0))) * DM + ch;
                a[j] = ok ? __hip_atomic_load(C.SUMA + o, __ATOMIC_RELAXED, __HIP_MEMORY_SCOPE_AGENT) : 1.f; bb[j] = ok ? __hip_atomic_load(C.SUMB + o, __ATOMIC_RELAXED, __HIP_MEMORY_SCOPE_AGENT) : 0.f; }
#pragma unroll
            for (int j = 0; j < 8; ++j) hcar = hcar * a[j] + bb[j]; }
        H0[tid] = hcar;
    }
    __syncthreads();
#pragma unroll
    for (int n = 0; n < 2; ++n) { const int chl = 32 * wave + 16 * n + fr; const float h0 = H0[chl];
#pragma unroll
        for (int m = 0; m < 8; ++m)
#pragma unroll
            for (int i = 0; i < 4; ++i) HB[(16 * m + 4 * fq + i) * XC_LD + chl] = f_to_bf16(acci[n][m][i] + accr[n][m][i] * h0); }
    __syncthreads();
    {
        const int cc = tid & 31, tg = tid >> 5;
#pragma unroll
        for (int t4 = 0; t4 < 8; t4 += 4) {
        u32x4 gav[4];
#pragma unroll
        for (int tt = 0; tt < 4; ++tt) gav[tt] = *(const u32x4*)(C.Z4 + (row_base + tg * 8 + t4 + tt) * 4096 + 1024 + h * 256 + cc * 8);
#pragma unroll
        for (int tt = 0; tt < 4; ++tt) { const int t = tg * 8 + t4 + tt;
            float hv[8], gv[8]; unpack8(*(const u32x4*)(HB + t * XC_LD + cc * 8), hv); unpack8(gav[tt], gv);
            u32x4 pk; pk.x = cvt_pk_bf16(hv[0] * gv[0], hv[1] * gv[1]); pk.y = cvt_pk_bf16(hv[2] * gv[2], hv[3] * gv[3]); pk.z = cvt_pk_bf16(hv[4] * gv[4], hv[5] * gv[5]); pk.w = cvt_pk_bf16(hv[6] * gv[6], hv[7] * gv[7]);
            *(u32x4*)(C.YA + (row_base + t) * 2048 + h * 256 + cc * 8) = pk; }
        asm volatile("" ::: "memory"); }
    }
    __syncthreads();
}

constexpr int WS_LD = 136;
__device__ __forceinline__ void mixer_b_tile(unsigned char* lds, const Ctx& C, int tile) {
    int tid_ = threadIdx.x; asm volatile("" : "+v"(tid_));
    const int tid = tid_, lane = tid & 63, wave = tid >> 6, fr = lane & 15, fq = lane >> 4;
    const int g = tile & 3, ck = (tile >> 2) & 31, b = tile >> 7;
    const size_t row_base = (size_t)b * SEQ + (size_t)ck * 128;
    bf16_t* WSL = (bf16_t*)lds;
    bf16_t* VT = (bf16_t*)(lds + 34816);
    bf16_t* SB = VT;
#pragma unroll
    for (int j = 0; j < 4; ++j) { const int q = tid + 512 * j, t = q >> 4, s8 = q & 15;
        *(u32x4*)(WSL + t * WS_LD + s8 * 8) = *(const u32x4*)(C.WSM + (size_t)g * 16384 + t * 128 + s8 * 8); }
    {
        const int wv = __builtin_amdgcn_readfirstlane(wave);
        u32x4 vv[4][2];
#pragma unroll
        for (int q = 0; q < 4; ++q) { const int ch = g * 256 + (4 * wv + q) * 8;
            vv[q][0] = *(const u32x4*)(C.Z4 + (row_base + 2 * lane) * 4096 + 3072 + ch); vv[q][1] = *(const u32x4*)(C.Z4 + (row_base + 2 * lane + 1) * 4096 + 3072 + ch); }
        f32x4 st = *(const f32x4*)(C.LNST + (row_base + 2 * lane) * 2);
        { const float m0 = st[0] * (1.0f / 1024.0f), m1 = st[2] * (1.0f / 1024.0f);
          st[1] = __builtin_amdgcn_rsqf(fmaxf(st[1] * (1.0f / 1024.0f) - m0 * m0, 0.f) + 1e-5f); st[3] = __builtin_amdgcn_rsqf(fmaxf(st[3] * (1.0f / 1024.0f) - m1 * m1, 0.f) + 1e-5f); st[0] = m0; st[2] = m1; }
#pragma unroll
        for (int q = 0; q < 4; ++q) { const int chl = (4 * wv + q) * 8, ch = g * 256 + chl;
            float v0[8], v1[8]; unpack8(vv[q][0], v0); unpack8(vv[q][1], v1);
            float lg[8], lb[8];
            { const f32x4 a0 = *(const f32x4*)(C.in[11] + ch), a1 = *(const f32x4*)(C.in[11] + ch + 4), b0 = *(const f32x4*)(C.in[12] + ch), b1 = *(const f32x4*)(C.in[12] + ch + 4);
#pragma unroll
              for (int j = 0; j < 4; ++j) { lg[j] = a0[j]; lg[4 + j] = a1[j]; lb[j] = b0[j]; lb[4 + j] = b1[j]; } }
#pragma unroll
            for (int j = 0; j < 8; ++j) { const float y0 = (v0[j] - st[0]) * st[1] * lg[j] + lb[j], y1 = (v1[j] - st[2]) * st[3] * lg[j] + lb[j];
                *(unsigned*)(VT + (chl + j) * WS_LD + 2 * lane) = cvt_pk_bf16(y0, y1); }
        }
    }
    __syncthreads();
    f32x4 acc[2][8];
#pragma unroll
    for (int n = 0; n < 2; ++n)
#pragma unroll
        for (int m = 0; m < 8; ++m) acc[n][m] = (f32x4){0.f, 0.f, 0.f, 0.f};
#pragma unroll
    for (int ks = 0; ks < 4; ++ks) {
        const bf16x8 b0 = *(const bf16x8*)(VT + (32 * wave + fr) * WS_LD + 32 * ks + 8 * fq), b1 = *(const bf16x8*)(VT + (32 * wave + 16 + fr) * WS_LD + 32 * ks + 8 * fq);
#pragma unroll
        for (int m = 0; m < 8; ++m) if (m >= 2 * ks) { const bf16x8 a = *(const bf16x8*)(WSL + (16 * m + fr) * WS_LD + 32 * ks + 8 * fq);
            acc[0][m] = __builtin_amdgcn_mfma_f32_16x16x32_bf16(a, b0, acc[0][m], 0, 0, 0);
            acc[1][m] = __builtin_amdgcn_mfma_f32_16x16x32_bf16(a, b1, acc[1][m], 0, 0, 0); }
    }
    __syncthreads();
    {
        const float* bs = C.in[14] + g * 128;
#pragma unroll
        for (int m = 0; m < 8; ++m) { const f32x4 bv = *(const f32x4*)(bs + 16 * m + 4 * fq);
#pragma unroll
            for (int n = 0; n < 2; ++n)
#pragma unroll
                for (int i = 0; i < 4; ++i) SB[(16 * m + 4 * fq + i) * XC_LD + 32 * wave + 16 * n + fr] = f_to_bf16(acc[n][m][i] + bv[i]); }
    }
    __syncthreads();
    {
        const int cc = tid & 31, tg = tid >> 5;
#pragma unroll
        for (int t4 = 0; t4 < 8; t4 += 4) {
        u32x4 uvv[4];
#pragma unroll
        for (int tt = 0; tt < 4; ++tt) uvv[tt] = *(const u32x4*)(C.Z4 + (row_base + tg * 8 + t4 + tt) * 4096 + 2048 + g * 256 + cc * 8);
#pragma unroll
        for (int tt = 0; tt < 4; ++tt) { const int t = tg * 8 + t4 + tt;
            float sv[8], uv[8]; unpack8(*(const u32x4*)(SB + t * XC_LD + cc * 8), sv); unpack8(uvv[tt], uv);
            u32x4 pk; pk.x = cvt_pk_bf16(sv[0] * uv[0], sv[1] * uv[1]); pk.y = cvt_pk_bf16(sv[2] * uv[2], sv[3] * uv[3]); pk.z = cvt_pk_bf16(sv[4] * uv[4], sv[5] * uv[5]); pk.w = cvt_pk_bf16(sv[6] * uv[6], sv[7] * uv[7]);
            *(u32x4*)(C.YA + (row_base + t) * 2048 + 1024 + g * 256 + cc * 8) = pk; }
        asm volatile("" ::: "memory"); }
    }
    __syncthreads();
}

#define LAS __attribute__((address_space(3)))
#define XB_TMO      128
#define XB_XCNT(j)  (256  + 64 * (j))
#define XB_XSUB(j)  (1280 + 64 * (j))
#define XB_XGEN(j)  (2304 + 64 * (j))
#define XB_TOP      3328
#define XB_TOPGEN   3392
#define XCD_BAR_WORDS 3456
#define XB_SPIN_CAP (1u << 18)

__device__ __forceinline__ unsigned xb_ld(unsigned* p)              { return __hip_atomic_load(p, __ATOMIC_RELAXED, __HIP_MEMORY_SCOPE_AGENT); }
__device__ __forceinline__ unsigned xb_add(unsigned* p, unsigned v) { return __hip_atomic_fetch_add(p, v, __ATOMIC_RELAXED, __HIP_MEMORY_SCOPE_AGENT); }
__device__ __forceinline__ unsigned xb_xcc_id() { return (unsigned)__builtin_amdgcn_s_getreg((3 << 11) | 20) & 0xFu; }
#define XB_SPIN(cond, bar) do { unsigned _sp = 0; while (cond) { __builtin_amdgcn_s_sleep(1); \
    if ((++_sp & 255u) == 0u) { if (xb_ld(&(bar)[XB_TMO])) break; if (_sp > XB_SPIN_CAP) { atomicAdd(&(bar)[XB_TMO], 1u); break; } } } } while (0)

struct XcdBarrier {
    unsigned* bar; unsigned x;
    volatile LAS unsigned* st;
};

__device__ __forceinline__ XcdBarrier xcd_barrier_post(unsigned* bar, volatile LAS unsigned* st) {
    XcdBarrier b; b.bar = bar; b.x = xb_xcc_id(); b.st = st;
    if (threadIdx.x == 0) (void)xb_add(&bar[XB_XCNT(b.x)], 1u);
    return b;
}
__device__ __forceinline__ void xcd_barrier_complete(unsigned* bar, unsigned x, unsigned& nloc, unsigned& nx) {
    const unsigned G = gridDim.x * gridDim.y * gridDim.z;
    unsigned sum, cnt, mine, sp = 0u;
    for (;;) {
        sum = 0u; cnt = 0u; mine = 0u;
#pragma unroll
        for (unsigned j = 0; j < 16; ++j) { const unsigned c = xb_ld(&bar[XB_XCNT(j)]); sum += c; cnt += (c > 0u) ? 1u : 0u; mine = (j == x) ? c : mine; }
        if (sum == G) break;
        __builtin_amdgcn_s_sleep(1);
        if ((++sp & 255u) == 0u) { if (xb_ld(&bar[XB_TMO])) break; if (sp > XB_SPIN_CAP) { atomicAdd(&bar[XB_TMO], 1u); break; } }
    }
    nloc = mine > 0u ? mine : 1u; nx = cnt > 0u ? cnt : 1u;
}

__device__ __forceinline__ void xcd_barrier(const XcdBarrier& b) {
    asm volatile("s_waitcnt vmcnt(0)" ::: "memory");
    __syncthreads();
    if (threadIdx.x == 0) {
        unsigned* bar = b.bar;
        __builtin_amdgcn_s_waitcnt(0);
        unsigned nloc = b.st[0], nx = b.st[1];
        if (nloc == 0u) { xcd_barrier_complete(bar, b.x, nloc, nx); b.st[0] = nloc; b.st[1] = nx; }
        const unsigned old = xb_add(&bar[XB_XSUB(b.x)], 1u);
        const unsigned gen = old / nloc;
        if (old + 1u == (gen + 1u) * nloc) {
            __builtin_amdgcn_fence(__ATOMIC_RELEASE, "agent");
            asm volatile("s_waitcnt vmcnt(0)" ::: "memory");
            const unsigned og = xb_add(&bar[XB_TOP], 1u);
            const unsigned tg = og / nx;
            if (og + 1u == (tg + 1u) * nx) xb_add(&bar[XB_TOPGEN], 1u);
            else XB_SPIN(xb_ld(&bar[XB_TOPGEN]) == tg, bar);
            __builtin_amdgcn_fence(__ATOMIC_ACQUIRE, "agent");
            xb_add(&bar[XB_XGEN(b.x)], 1u);
            asm volatile("s_waitcnt vmcnt(0)" ::: "memory");
        } else {
            XB_SPIN(xb_ld(&bar[XB_XGEN(b.x)]) == gen, bar);
            __builtin_amdgcn_fence(__ATOMIC_ACQUIRE, "agent");
            asm volatile("s_waitcnt vmcnt(0)" ::: "memory");
        }
    }
    __syncthreads();
}
__global__ void __launch_bounds__(512, 2) hybrid_fwd(Params P) {
    extern __shared__ __attribute__((aligned(16))) unsigned char lds[];
    cg::grid_group grid = cg::this_grid();
    const int G = gridDim.x, NGW = G * 8;
    Ctx C;
#pragma unroll
    for (int i = 0; i < 21; ++i) C.in[i] = P.in[i];
    C.out = P.out; C.ws = P.ws;
    unsigned char* ws = P.ws;
    C.WIN = (bf16_t*)(ws + WS_WIN); C.WOA = (bf16_t*)(ws + WS_WOA); C.WOB = (bf16_t*)(ws + WS_WOB); C.WOUT = (bf16_t*)(ws + WS_WOUT); C.WUP = (bf16_t*)(ws + WS_WUP); C.WDN = (bf16_t*)(ws + WS_WDN);
    C.WG = (bf16_t*)(ws + WS_WG); C.WSM = (bf16_t*)(ws + WS_WSM); C.Z4 = (bf16_t*)(ws + WS_Z4); C.ZG = (bf16_t*)P.out; C.XN = (bf16_t*)(ws + WS_XN + 1 * MiB + 8192); C.YA = (bf16_t*)(ws + WS_YA); C.YB = (bf16_t*)(ws + WS_YB);
    C.MRG = (bf16_t*)(ws + WS_MRG); C.H1B = (bf16_t*)(ws + WS_H1B); C.U = (bf16_t*)(ws + WS_U);
    C.SUMA = (float*)(ws + WS_SUMA); C.SUMB = (float*)(ws + WS_SUMB); C.LNST = (float*)(ws + WS_LNST); C.SS1 = (float*)(ws + WS_SS1); C.SS2 = (float*)(ws + WS_SS2); C.TMP = (float*)(ws + WS_TMP); C.MASK = (unsigned*)(ws + WS_BAR) + 4096;
    PG8_LAS unsigned char* ldsl = (PG8_LAS unsigned char*)lds;
    volatile LAS unsigned* bst = (volatile LAS unsigned*)(ldsl + LDS_BYTES - 16);
    if (threadIdx.x < 4) bst[threadIdx.x] = 0u;
    __syncthreads();
    const XcdBarrier bar = xcd_barrier_post((unsigned*)(ws + WS_BAR), bst);
    if (G > 65535) grid.sync();
#define GRID_BAR() xcd_barrier(bar)

    {
        int t0_ = threadIdx.x; asm volatile("" : "+v"(t0_)); const int tid = t0_, lane = tid & 63, wave = tid >> 6, gw = blockIdx.x * 8 + wave;
        float* scr = (float*)(lds + wave * 8448);
        constexpr int I_IN = 16 * 192, I_SQ = 16 * 32, I_UP = 16 * 128, I_DN = 64 * 32, I_G = 4 * 8;
        constexpr int NITEMS = I_IN + 3 * I_SQ + I_UP + I_DN + 8 * I_G;
        for (int it = gw; it < NITEMS; it += NGW) {
            int r = it;
            if (r < I_IN) { tr_item(C.in[2], DIN, DM, C.WIN, nullptr, scr, r, lane); continue; } r -= I_IN;
            if (r < I_SQ) { tr_item(C.in[10], DM, DM, C.WOA, nullptr, scr, r, lane, 2048); continue; } r -= I_SQ;
            if (r < I_SQ) { tr_item(C.in[15], DM, DM, C.WOA + 1024, nullptr, scr, r, lane, 2048); continue; } r -= I_SQ;
            if (r < I_SQ) { tr_item(C.in[16], DM, DM, C.WOUT, nullptr, scr, r, lane); continue; } r -= I_SQ;
            if (r < I_UP) { tr_item(C.in[18], DFF, DM, C.WUP, C.in[17], scr, r, lane); continue; } r -= I_UP;
            if (r < I_DN) { tr_item(C.in[19], DM, DFF, C.WDN, nullptr, scr, r, lane); continue; } r -= I_DN;
            { const int mat = r / I_G, item = r % I_G, hh = mat >> 1, gate = mat & 1;
              tr_item(C.in[gate ? 7 : 5] + (size_t)hh * 65536, 256, 256, C.WG + (size_t)(hh * 2 + gate) * 65536, nullptr, scr, item, lane); }
        }
        for (int i = blockIdx.x * 512 + tid; i < 4 * 128 * 128; i += G * 512) { const int t = (i >> 7) & 127, s = i & 127; C.WSM[i] = (s <= t) ? pg8::cvt_pk_bf16(C.in[13][i], 0.f) & 0xffffu : 0; }
        for (int i = blockIdx.x * 512 + tid; i < MTOK; i += G * 512) { C.SS1[i] = 0.f; C.SS2[i] = 0.f; C.LNST[2 * i] = 0.f; C.LNST[2 * i + 1] = 0.f; }
        for (int m = gw; m < MTOK; m += 2 * NGW) {
            const int m2 = m + NGW;
            if (m2 < MTOK) rms_rows2_to_bf16(C.in[0] + (size_t)m * DM, C.in[0] + (size_t)m2 * DM, C.in[1], C.XN + (size_t)m * DM, C.XN + (size_t)m2 * DM, lane);
            else rms_row_to_bf16(C.in[0] + (size_t)m * DM, C.in[1], C.XN + (size_t)m * DM, lane);
        }
    }
    GRID_BAR();
    { pg8::Gemm g{C.XN, C.WIN, MTOK, DIN, DM}; pg8::StaticOrder S; S.init(MTOK, DIN, G, (int)blockIdx.x, (blockIdx.x & 1) ? 3 : 0);
      pg8::EpiZ E{C.Z4, C.ZG, C.LNST};
      pg8::gemm_phase<pg8::EpiZ, pg8::StaticOrder, true, true>(ldsl, g, S, E); }
    GRID_BAR();
    if (blockIdx.x & 2) for (int t = blockIdx.x; t < 512; t += G) mixer_b_tile(lds, C, t);
    for (int t = blockIdx.x; t < 512; t += G) mixer_a_tile(lds, C, t);
    if (!(blockIdx.x & 2)) for (int t = blockIdx.x; t < 512; t += G) mixer_b_tile(lds, C, t);
    GRID_BAR();
    { pg8::Gemm g{C.YA, C.WOA, MTOK, DM, 2 * DM}; pg8::StaticOrder S; S.init(MTOK, DM, G, (int)blockIdx.x);
      pg8::EpiMerge2 E{(const unsigned char*)C.ZG, C.MRG};
      pg8::gemm_phase<pg8::EpiMerge2, pg8::StaticOrder, true, true>(ldsl, g, S, E); }
    GRID_BAR();
    { pg8::Gemm g{C.MRG, C.WOUT, MTOK, DM, DM}; pg8::StaticOrder S; S.init(MTOK, DM, G, (int)blockIdx.x);
      pg8::EpiH1 E{C.in[0], C.out, C.H1B, C.SS1, G == 256 ? 0 : 1};
      pg8::gemm_phase<pg8::EpiH1, pg8::StaticOrder, true, true>(ldsl, g, S, E); }
    GRID_BAR();
    { pg8::Gemm g{C.H1B, C.WUP, MTOK, DFF, DM}; pg8::StaticOrder S; S.init(MTOK, DFF, G, (int)blockIdx.x);
      pg8::EpiUp E{C.SS1, C.U};
      pg8::gemm_phase<pg8::EpiUp, pg8::StaticOrder, true, true>(ldsl, g, S, E); }
    GRID_BAR();
    if (G == 256) {
      pg8::Gemm g{C.U, C.WDN, MTOK, DM, DFF}; pg8::StaticOrder S; S.init(MTOK, DM, G, (int)blockIdx.x);
      pg8::EpiDownNorm E{C.H1B, C.out, C.SS2, C.MASK + 1024, C.in[20]};
      pg8::gemm_phase<pg8::EpiDownNorm, pg8::StaticOrder, false, true>(ldsl, g, S, E);
    } else {
      { pg8::Gemm g{C.U, C.WDN, MTOK, DM, DFF}; pg8::StaticOrder S; S.init(MTOK, DM, G, (int)blockIdx.x);
        pg8::EpiDown E{C.out, C.SS2};
        pg8::gemm_phase<pg8::EpiDown, pg8::StaticOrder, true, true>(ldsl, g, S, E); }
      GRID_BAR();
      int t8_ = threadIdx.x; asm volatile("" : "+v"(t8_)); const int lane = t8_ & 63, gw = blockIdx.x * 8 + (t8_ >> 6);
      for (int m = gw; m < MTOK; m += NGW) {
        f32x4* xr = (f32x4*)(C.out + (size_t)m * DM) + lane; const f32x4* gr = (const f32x4*)C.in[20] + lane;
        const float rs = 1.0f / sqrtf(C.SS2[m] * (1.0f / 1024.0f) + 1e-6f);
#pragma unroll
        for (int j = 0; j < 4; ++j) xr[64 * j] = xr[64 * j] * rs * gr[64 * j];
      }
    }
}

extern "C" void kernel_launch(void* const* d_in, const int* in_sizes, int n_in, void* d_out, int out_size, void* d_ws, size_t ws_size, hipStream_t stream) {
    static int grid_blocks = 0;
    if (grid_blocks == 0) {
        if (n_in != 21 || out_size != MTOK * DM || ws_size < WS_END) { fprintf(stderr, "kernel_launch: unexpected shapes (n_in %d, out %d, ws %zu)\n", n_in, out_size, ws_size); grid_blocks = -1; return; }
        int dev = 0, cus = 0, per_cu = 0;
        hipGetDevice(&dev); hipDeviceGetAttribute(&cus, hipDeviceAttributeMultiprocessorCount, dev);
        if (hipFuncSetAttribute((const void*)hybrid_fwd, hipFuncAttributeMaxDynamicSharedMemorySize, LDS_BYTES) != hipSuccess) fprintf(stderr, "kernel_launch: hipFuncSetAttribute failed\n");
        if (hipOccupancyMaxActiveBlocksPerMultiprocessor(&per_cu, (const void*)hybrid_fwd, 512, LDS_BYTES) != hipSuccess || per_cu < 1) { fprintf(stderr, "kernel_launch: occupancy query says %d\n", per_cu); per_cu = 1; }
        (void)hipGetLastError();
        grid_blocks = cus * 1;
    }
    if (grid_blocks < 0) return;
    Params p{};
    for (int i = 0; i < 21; ++i) p.in[i] = (const float*)d_in[i];
    p.out = (float*)d_out; p.ws = (unsigned char*)d_ws;
    if (hipMemsetAsync((char*)d_ws + WS_BAR, 0, (4096 + 1024 + 64 * 64) * sizeof(unsigned), stream) != hipSuccess) { fprintf(stderr, "kernel_launch: memset failed\n"); return; }
    void* args[] = {&p};
    hipError_t e = hipLaunchCooperativeKernel((const void*)hybrid_fwd, dim3(grid_blocks), dim3(512), args, LDS_BYTES, stream);
    if (e != hipSuccess) fprintf(stderr, "cooperative launch failed: %s (grid %d)\n", hipGetErrorString(e), grid_blocks);
}
```

```cpp
#include <hip/hip_runtime.h>
#include <hip/hip_cooperative_groups.h>
#include <cstdio>
#include <cstdint>
namespace cg = cooperative_groups;
namespace pg8 {
#define PG8_LAS __attribute__((address_space(3)))
typedef unsigned short bf16_t;
typedef short bf16x8 __attribute__((ext_vector_type(8)));
typedef float f32x4 __attribute__((ext_vector_type(4)));
typedef unsigned u32x4 __attribute__((ext_vector_type(4)));
constexpr int BM = 256, BK = 64, HALF = 128, HTB = HALF * BK * 2  , STAGE_BYTES = 8 * HTB, NXCD = 8, WGM = 8;

__host__ __device__ __forceinline__ int lds_byte(int r, int c) { const int st = (r >> 4) * 2 + (c >> 5), rr = r & 15, cc = c & 31, ob = rr * 64 + cc * 2; return st * 1024 + (ob ^ (((ob >> 9) & 1) << 5)); }
__host__ __device__ __forceinline__ void stage_rc(int b, int& R, int& C) { const int st = b / 1024, sb = b % 1024, swz = sb ^ (((sb >> 9) & 1) << 5); R = (st >> 1) * 16 + swz / 64; C = (st & 1) * 32 + (swz % 64) / 2; }
__host__ __device__ __forceinline__ int perm32(int rho) { const int n = rho >> 4, i = rho & 15; return 8 * (i >> 2) + 4 * n + (i & 3); }

struct Unit { int pm, pn; };
struct Gemm { const bf16_t* A; const bf16_t* Bt; int M, N, K; };

struct StaticOrder {
    int nM, nN, nwg, G, c, rot, nround;
    __host__ __device__ void init(int M, int N, int G_, int c_, int rot_ = 0) { nM = M / BM; nN = N / BM; nwg = nM * nN; G = G_; c = c_; nround = nwg / G; rot = (nwg % G == 0 && nround > 1) ? rot_ % nround : 0; }
    __host__ __device__ bool next(int i, Unit& u) const {
        if ((long)i * G + c >= nwg) return false;
        int ii = i + rot; if (rot && ii >= nround) ii -= nround;
        const long L = (long)ii * G + c;
        int wgid = (int)L; { const int q = nwg / NXCD, r = nwg % NXCD, xcd = wgid % NXCD, off = wgid / NXCD; wgid = (xcd < r ? xcd * (q + 1) : r * (q + 1) + (xcd - r) * q) + off; }
        const int nig = WGM * nN, gid = wgid / nig, fm = gid * WGM, gsz = (nM - fm) < WGM ? (nM - fm) : WGM;
        u.pm = fm + ((wgid % nig) % gsz); u.pn = (wgid % nig) / gsz; return true;
    }
    __device__ __forceinline__ void a_ready(const Unit&) const {}
    __device__ __forceinline__ void done(const Unit&) const {}
};

__device__ __forceinline__ unsigned cvt_pk_bf16(float lo, float hi) { unsigned r; asm volatile("v_cvt_pk_bf16_f32 %0, %1, %2" : "=v"(r) : "v"(lo), "v"(hi)); return r; }
__device__ __forceinline__ float sigmoid_f(float x) { return __builtin_amdgcn_rcpf(1.0f + __builtin_amdgcn_exp2f(-1.4426950409f * x)); }
__device__ __forceinline__ float gelu_tanh_f(float x) { const float t = x * (1.5957691216f + 0.0713548163f * x * x); return x * __builtin_amdgcn_rcpf(1.0f + __builtin_amdgcn_exp2f(-1.4426950409f * t)); }
typedef float f32x2e __attribute__((ext_vector_type(2)));
__device__ __forceinline__ f32x2e gelu_tanh_pk(f32x2e x) { const f32x2e x2 = x * x; const f32x2e t = x * (x2 * (-0.1029432407f) + (-2.3022081925f));
    f32x2e e; e.x = __builtin_amdgcn_exp2f(t.x); e.y = __builtin_amdgcn_exp2f(t.y); const f32x2e d = e + 1.0f; f32x2e r; r.x = __builtin_amdgcn_rcpf(d.x); r.y = __builtin_amdgcn_rcpf(d.y); return x * r; }
__device__ __forceinline__ f32x2e sigmoid_pk(f32x2e x) { const f32x2e t = x * (-1.4426950409f); f32x2e e; e.x = __builtin_amdgcn_exp2f(t.x); e.y = __builtin_amdgcn_exp2f(t.y); const f32x2e d = e + 1.0f;
    f32x2e r; r.x = __builtin_amdgcn_rcpf(d.x); r.y = __builtin_amdgcn_rcpf(d.y); return r; }
__device__ __forceinline__ float bf_lo(unsigned w) { return __uint_as_float(w << 16); }
__device__ __forceinline__ float bf_hi(unsigned w) { return __uint_as_float(w & 0xffff0000u); }
__device__ __forceinline__ u32x4 pack8(const f32x4 v0, const f32x4 v1) { u32x4 w; w.x = cvt_pk_bf16(v0[0], v0[1]); w.y = cvt_pk_bf16(v0[2], v0[3]); w.z = cvt_pk_bf16(v1[0], v1[1]); w.w = cvt_pk_bf16(v1[2], v1[3]); return w; }

struct EpiZ {
    static constexpr bool PERM = true, AFTER_DRAIN = false, MIDK = false;
    bf16_t* Z4; bf16_t* ZG; float* LNS;
    template <int MODE> __device__ __forceinline__ void body(const f32x4 (&acc)[2][2][4][2], int pn, int row0, int wc, int fq) const {
        typedef unsigned u32x2v __attribute__((ext_vector_type(2)));
        const int col0 = (MODE == 3 ? (pn - 16) * BM : pn * BM) + wc * 32 + 8 * fq;
#pragma unroll
        for (int ai = 0; ai < 2; ++ai)
#pragma unroll
            for (int m = 0; m < 4; ++m) { const size_t row = (size_t)(row0 + ai * HALF + m * 16); float s = 0.f, q = 0.f;
#pragma unroll
                for (int bj = 0; bj < 2; ++bj) { f32x4 v0 = acc[ai][bj][m][0], v1 = acc[ai][bj][m][1];
                    if (MODE == 3) {
                        unsigned w0 = 0u, w1 = 0u;
#pragma unroll
                        for (int j = 0; j < 4; j += 2) { const f32x2e s0 = sigmoid_pk((f32x2e){v0[j], v0[j + 1]}) * 255.0f, s1 = sigmoid_pk((f32x2e){v1[j], v1[j + 1]}) * 255.0f;
                            w0 = __builtin_amdgcn_cvt_pk_u8_f32(fmaxf(__builtin_rintf(s0.x), 1.0f), j, w0); w0 = __builtin_amdgcn_cvt_pk_u8_f32(fmaxf(__builtin_rintf(s0.y), 1.0f), j + 1, w0);
                            w1 = __builtin_amdgcn_cvt_pk_u8_f32(fmaxf(__builtin_rintf(s1.x), 1.0f), j, w1); w1 = __builtin_amdgcn_cvt_pk_u8_f32(fmaxf(__builtin_rintf(s1.y), 1.0f), j + 1, w1); }
                        *(u32x2v*)((unsigned char*)ZG + row * 2048 + col0 + bj * HALF) = (u32x2v){w0, w1};
                    } else {
                        if (MODE >= 1) {
#pragma unroll
                            for (int j = 0; j < 4; j += 2) { const f32x2e a = gelu_tanh_pk((f32x2e){v0[j], v0[j + 1]}), b = gelu_tanh_pk((f32x2e){v1[j], v1[j + 1]}); v0[j] = a.x; v0[j + 1] = a.y; v1[j] = b.x; v1[j + 1] = b.y; } }
                        if (MODE == 2) { s += (v0[0] + v0[1]) + (v0[2] + v0[3]) + (v1[0] + v1[1]) + (v1[2] + v1[3]);
                            q += (v0[0] * v0[0] + v0[1] * v0[1]) + (v0[2] * v0[2] + v0[3] * v0[3]) + (v1[0] * v1[0] + v1[1] * v1[1]) + (v1[2] * v1[2] + v1[3] * v1[3]); }
                        *(u32x4*)(Z4 + row * 4096 + col0 + bj * HALF) = pack8(v0, v1); } }
                if (MODE == 2) { s += __shfl_xor(s, 16); s += __shfl_xor(s, 32); q += __shfl_xor(q, 16); q += __shfl_xor(q, 32);
                    if (fq == 0) { float* p = LNS + row * 2; __hip_atomic_fetch_add(p, s, __ATOMIC_RELAXED, __HIP_MEMORY_SCOPE_AGENT); __hip_atomic_fetch_add(p + 1, q, __ATOMIC_RELAXED, __HIP_MEMORY_SCOPE_AGENT); } } }
    }
    __device__ __forceinline__ void operator()(const f32x4 (&acc)[2][2][4][2], const Unit& u, int wr, int wc, int fr, int fq) const {
        const int sec = u.pn >> 2, row0 = u.pm * BM + wr * 64 + fr;
        if (sec == 0) body<0>(acc, u.pn, row0, wc, fq);
        else if (sec < 3) body<1>(acc, u.pn, row0, wc, fq);
        else if (sec == 3) body<2>(acc, u.pn, row0, wc, fq);
        else body<3>(acc, u.pn, row0, wc, fq);
    }
};
struct EpiMerge2 {
    static constexpr bool PERM = true, AFTER_DRAIN = false, MIDK = true;
    const unsigned char* G; bf16_t* O;
    typedef unsigned u32x2v __attribute__((ext_vector_type(2)));
    static __device__ __forceinline__ f32x4 ub4(unsigned w) { return (f32x4){(float)(w & 0xffu), (float)((w >> 8) & 0xffu), (float)((w >> 16) & 0xffu), (float)(w >> 24)}; }
    __device__ __forceinline__ void mid(f32x4 (&acc)[2][2][4][2], const Unit& u, int wr, int wc, int fr, int fq) const {
        int row0 = u.pm * BM + wr * 64 + fr, col0 = u.pn * BM + wc * 32 + 8 * fq;
        asm volatile("" : "+v"(row0), "+v"(col0));
#pragma unroll
        for (int ai = 0; ai < 2; ++ai)
#pragma unroll
            for (int m = 0; m < 4; ++m) { const unsigned char* gp = G + (size_t)(row0 + ai * HALF + m * 16) * 2048 + col0;
#pragma unroll
                for (int bj = 0; bj < 2; ++bj) { const u32x2v a = *(const u32x2v*)(gp + bj * HALF), b = *(const u32x2v*)(gp + 1024 + bj * HALF);
                    const f32x4 a0 = ub4(a.x), a1 = ub4(a.y), b0 = ub4(b.x), b1 = ub4(b.y);
#pragma unroll
                    for (int j = 0; j < 4; ++j) { acc[ai][bj][m][0][j] *= a0[j] * __builtin_amdgcn_rcpf(b0[j]); acc[ai][bj][m][1][j] *= a1[j] * __builtin_amdgcn_rcpf(b1[j]); }
                    asm volatile("" ::: "memory"); } }
    }
    __device__ __forceinline__ void operator()(const f32x4 (&acc)[2][2][4][2], const Unit& u, int wr, int wc, int fr, int fq) const {
        const int row0 = u.pm * BM + wr * 64 + fr, col0 = u.pn * BM + wc * 32 + 8 * fq;
        u32x2v gbv[2][4][2];
#pragma unroll
        for (int ai = 0; ai < 2; ++ai)
#pragma unroll
            for (int m = 0; m < 4; ++m)
#pragma unroll
                for (int bj = 0; bj < 2; ++bj) gbv[ai][m][bj] = *(const u32x2v*)(G + (size_t)(row0 + ai * HALF + m * 16) * 2048 + 1024 + col0 + bj * HALF);
#pragma unroll
        for (int ai = 0; ai < 2; ++ai)
#pragma unroll
            for (int m = 0; m < 4; ++m) { const size_t row = (size_t)(row0 + ai * HALF + m * 16);
#pragma unroll
                for (int bj = 0; bj < 2; ++bj) { const int c = col0 + bj * HALF; const u32x2v b = gbv[ai][m][bj];
                    const f32x4 b0 = ub4(b.x) * (1.0f / 255.0f), b1 = ub4(b.y) * (1.0f / 255.0f);
                    *(u32x4*)(O + row * 1024 + c) = pack8(acc[ai][bj][m][0] * b0, acc[ai][bj][m][1] * b1); } }
    }
};
struct EpiH1 {
    static constexpr bool PERM = true, AFTER_DRAIN = false, MIDK = false;
    const float* X; float* H; bf16_t* HB; float* SS; int wH;
    template <bool WH> __device__ __forceinline__ void body(const f32x4 (&acc)[2][2][4][2], const Unit& u, int wr, int wc, int fr, int fq) const {
        const int row0 = u.pm * BM + wr * 64 + fr, col0 = u.pn * BM + wc * 32 + 8 * fq;
#pragma unroll
        for (int ai = 0; ai < 2; ++ai)
#pragma unroll
          for (int mh = 0; mh < 4; mh += 2) {
            f32x4 xv[2][2][2];
#pragma unroll
            for (int m = 0; m < 2; ++m)
#pragma unroll
                for (int bj = 0; bj < 2; ++bj) { const float* xp = X + (size_t)(row0 + ai * HALF + (mh + m) * 16) * 1024 + col0 + bj * HALF; xv[m][bj][0] = *(const f32x4*)xp; xv[m][bj][1] = *(const f32x4*)(xp + 4); }
#pragma unroll
            for (int m = 0; m < 2; ++m) { const size_t row = (size_t)(row0 + ai * HALF + (mh + m) * 16); float s = 0.f;
#pragma unroll
                for (int bj = 0; bj < 2; ++bj) { const int c = col0 + bj * HALF;
                    const f32x4 v0 = xv[m][bj][0] + acc[ai][bj][mh + m][0], v1 = xv[m][bj][1] + acc[ai][bj][mh + m][1];
                    if (WH) { *(f32x4*)(H + row * 1024 + c) = v0; *(f32x4*)(H + row * 1024 + c + 4) = v1; }
                    *(u32x4*)(HB + row * 1024 + c) = pack8(v0, v1);
                    s += (v0[0] * v0[0] + v0[1] * v0[1]) + (v0[2] * v0[2] + v0[3] * v0[3]) + (v1[0] * v1[0] + v1[1] * v1[1]) + (v1[2] * v1[2] + v1[3] * v1[3]); }
                s += __shfl_xor(s, 16); s += __shfl_xor(s, 32);
                if (fq == 0) __hip_atomic_fetch_add(SS + row, s, __ATOMIC_RELAXED, __HIP_MEMORY_SCOPE_AGENT); }
            asm volatile("" ::: "memory");
          }
    }
    __device__ __forceinline__ void operator()(const f32x4 (&acc)[2][2][4][2], const Unit& u, int wr, int wc, int fr, int fq) const {
        if (wH) body<true>(acc, u, wr, wc, fr, fq); else body<false>(acc, u, wr, wc, fr, fq);
    }
};
struct EpiUp {
    static constexpr bool PERM = true, AFTER_DRAIN = false, MIDK = false;
    const float* SS; bf16_t* U;
    __device__ __forceinline__ void operator()(const f32x4 (&acc)[2][2][4][2], const Unit& u, int wr, int wc, int fr, int fq) const {
        const int row0 = u.pm * BM + wr * 64 + fr, col0 = u.pn * BM + wc * 32 + 8 * fq;
        float ssv[2][4];
#pragma unroll
        for (int ai = 0; ai < 2; ++ai)
#pragma unroll
            for (int m = 0; m < 4; ++m) ssv[ai][m] = SS[row0 + ai * HALF + m * 16];
#pragma unroll
        for (int ai = 0; ai < 2; ++ai)
#pragma unroll
            for (int m = 0; m < 4; ++m) { const size_t row = (size_t)(row0 + ai * HALF + m * 16);
                const float rs = __builtin_amdgcn_rsqf(ssv[ai][m] * (1.0f / 1024.0f) + 1e-6f);
#pragma unroll
                for (int bj = 0; bj < 2; ++bj) { f32x4 v0 = acc[ai][bj][m][0] * rs, v1 = acc[ai][bj][m][1] * rs;
#pragma unroll
                    for (int j = 0; j < 4; ++j) { const float a = fmaxf(v0[j], 0.f), b = fmaxf(v1[j], 0.f); v0[j] = a * a; v1[j] = b * b; }
                    *(u32x4*)(U + row * 4096 + col0 + bj * HALF) = pack8(v0, v1); } }
    }
};
struct EpiDown {
    static constexpr bool PERM = false, AFTER_DRAIN = false, MIDK = false;
    float* H; float* SS;
    __device__ __forceinline__ void operator()(const f32x4 (&acc)[2][2][4][2], const Unit& u, int wr, int wc, int fr, int fq) const {
        const int row0 = u.pm * BM + wr * 64 + fr, col0 = u.pn * BM + wc * 32 + 4 * fq;
#pragma unroll
        for (int ai = 0; ai < 2; ++ai)
#pragma unroll
            for (int m = 0; m < 4; ++m) { const size_t row = (size_t)(row0 + ai * HALF + m * 16); float s = 0.f;
#pragma unroll
                for (int bj = 0; bj < 2; ++bj)
#pragma unroll
                    for (int n = 0; n < 2; ++n) { float* p = H + row * 1024 + col0 + bj * HALF + n * 16; const f32x4 v = *(const f32x4*)p + acc[ai][bj][m][n]; *(f32x4*)p = v;
                        s += (v[0] * v[0] + v[1] * v[1]) + (v[2] * v[2] + v[3] * v[3]); }
                s += __shfl_xor(s, 16); s += __shfl_xor(s, 32);
                if (fq == 0) __hip_atomic_fetch_add(SS + row, s, __ATOMIC_RELAXED, __HIP_MEMORY_SCOPE_AGENT); }
    }
};

struct EpiDownNorm {
    static constexpr bool PERM = true, AFTER_DRAIN = true, MIDK = false;
    const bf16_t* HB; float* OUT; float* SS; unsigned* CNT; const float* g;
    __device__ __forceinline__ void fused(f32x4 (&acc)[2][2][4][2], const Unit& u, int wr, int wc, int fr, int fq, PG8_LAS unsigned char* lds, int wid, int lane) const {
        const int row0 = u.pm * BM + wr * 64 + fr, col0 = u.pn * BM + wc * 32 + 8 * fq;
        u32x4 hbv[2][4][2];
#pragma unroll
        for (int ai = 0; ai < 2; ++ai)
#pragma unroll
            for (int m = 0; m < 4; ++m)
#pragma unroll
                for (int bj = 0; bj < 2; ++bj) hbv[ai][m][bj] = *(const u32x4*)(HB + (size_t)(row0 + ai * HALF + m * 16) * 1024 + col0 + bj * HALF);
        float old8[2][4];
#pragma unroll
        for (int ai = 0; ai < 2; ++ai)
#pragma unroll
            for (int m = 0; m < 4; ++m) { const size_t row = (size_t)(row0 + ai * HALF + m * 16); float s = 0.f;
#pragma unroll
                for (int bj = 0; bj < 2; ++bj) { const u32x4 hb = hbv[ai][m][bj];
                    const f32x4 v0 = (f32x4){bf_lo(hb.x), bf_hi(hb.x), bf_lo(hb.y), bf_hi(hb.y)} + acc[ai][bj][m][0], v1 = (f32x4){bf_lo(hb.z), bf_hi(hb.z), bf_lo(hb.w), bf_hi(hb.w)} + acc[ai][bj][m][1];
                    acc[ai][bj][m][0] = v0; acc[ai][bj][m][1] = v1;
                    s += (v0[0] * v0[0] + v0[1] * v0[1]) + (v0[2] * v0[2] + v0[3] * v0[3]) + (v1[0] * v1[0] + v1[1] * v1[1]) + (v1[2] * v1[2] + v1[3] * v1[3]); }
                s += __shfl_xor(s, 16); s += __shfl_xor(s, 32);
                old8[ai][m] = (fq == 0) ? __hip_atomic_fetch_add(SS + row, s, __ATOMIC_RELAXED, __HIP_MEMORY_SCOPE_AGENT) : 0.f; }
        asm volatile("s_waitcnt vmcnt(0)" :: "v"(old8[0][0]), "v"(old8[0][1]), "v"(old8[0][2]), "v"(old8[0][3]), "v"(old8[1][0]), "v"(old8[1][1]), "v"(old8[1][2]), "v"(old8[1][3]) : "memory");
        __syncthreads();
        if (threadIdx.x == 0) {
            unsigned* c = CNT + 64 * u.pm;
            __hip_atomic_fetch_add(c, 1u, __ATOMIC_RELAXED, __HIP_MEMORY_SCOPE_AGENT);
            unsigned sp = 0u;
            while (__hip_atomic_load(c, __ATOMIC_RELAXED, __HIP_MEMORY_SCOPE_AGENT) < 4u) { __builtin_amdgcn_s_sleep(1); if (++sp > (1u << 22)) break; }
            __builtin_amdgcn_fence(__ATOMIC_ACQUIRE, "agent");
            asm volatile("s_waitcnt vmcnt(0)" ::: "memory");
        }
        __syncthreads();
        f32x4 gv[2][2]; float ssv[2][4];
#pragma unroll
        for (int bj = 0; bj < 2; ++bj)
#pragma unroll
            for (int n = 0; n < 2; ++n) gv[bj][n] = *(const f32x4*)(g + col0 + bj * HALF + 4 * n);
#pragma unroll
        for (int ai = 0; ai < 2; ++ai)
#pragma unroll
            for (int m = 0; m < 4; ++m) ssv[ai][m] = __hip_atomic_load(SS + (size_t)(row0 + ai * HALF + m * 16), __ATOMIC_RELAXED, __HIP_MEMORY_SCOPE_AGENT);
#pragma unroll
        for (int ai = 0; ai < 2; ++ai)
#pragma unroll
            for (int m = 0; m < 4; ++m) { const size_t row = (size_t)(row0 + ai * HALF + m * 16);
                const float rs = __builtin_amdgcn_rsqf(ssv[ai][m] * (1.0f / 1024.0f) + 1e-6f);
#pragma unroll
                for (int bj = 0; bj < 2; ++bj)
#pragma unroll
                    for (int n = 0; n < 2; ++n) *(f32x4*)(OUT + row * 1024 + col0 + bj * HALF + 4 * n) = acc[ai][bj][m][n] * rs * gv[bj][n]; }
    }
};
template <class Epi, class Sched, bool ALIGN_EPI = false, bool SP2 = false>
__device__ __forceinline__ void gemm_phase(PG8_LAS unsigned char* lds, const Gemm g, const Sched& S, const Epi& E) {
    int tid_ = threadIdx.x; asm volatile("" : "+v"(tid_));
    const int tid = tid_, wid = __builtin_amdgcn_readfirstlane(tid >> 6), lane = tid & 63, wr = wid >> 2, wc = wid & 3, fr = lane & 15, fq = lane >> 4;
    const int K = g.K, nt = K / BK;
    unsigned voffA[2], voffB[2];
#pragma unroll
    for (int i = 0; i < 2; ++i) { int R, C; stage_rc(tid * 16 + i * 8192, R, C); const int Rb = Epi::PERM ? ((R & ~31) + perm32(R & 31)) : R;
        voffA[i] = (unsigned)(R * K + C) * 2u; voffB[i] = (unsigned)(Rb * K + C) * 2u; }
    const size_t kstep = (size_t)(BK * 2);
    const size_t hstep = (size_t)HALF * K * 2;
    const size_t tstep = 2 * hstep;
    const unsigned ldsw = (unsigned)wid * 1024u;
    const int aoff = lds_byte(wr * 64 + fr, fq * 8), boff = lds_byte(wc * 32 + fr, fq * 8);
#define PG8_SA(b, h) (((b) * 2 + (h)) * HTB)
#define PG8_SB(b, h) ((4 + (b) * 2 + (h)) * HTB)
#define PG8_STAGE(bufoff, gbase, voff) do { _Pragma("unroll") for (int _i = 0; _i < 2; ++_i) \
        __builtin_amdgcn_global_load_lds((const unsigned*)((const char*)(gbase) + (voff)[_i]), (PG8_LAS unsigned*)(lds + (bufoff) + ldsw + _i * 8192), 16, 0, 0); } while (0)
#define PG8_LDA(dst, b, h) do { _Pragma("unroll") for (int m = 0; m < 4; ++m) _Pragma("unroll") for (int k = 0; k < 2; ++k) dst[m][k] = *(const PG8_LAS bf16x8*)(lds + PG8_SA(b, h) + aoff + m * 2048 + k * 1024); } while (0)
#define PG8_LDB(dst, b, h) do { _Pragma("unroll") for (int n = 0; n < 2; ++n) _Pragma("unroll") for (int k = 0; k < 2; ++k) dst[n][k] = *(const PG8_LAS bf16x8*)(lds + PG8_SB(b, h) + boff + n * 2048 + k * 1024); } while (0)
#define PG8_MMA(ai, bj, At, Bt) do { __builtin_amdgcn_s_setprio(1); _Pragma("unroll") for (int m = 0; m < 4; ++m) _Pragma("unroll") for (int n = 0; n < 2; ++n) _Pragma("unroll") for (int k = 0; k < 2; ++k) \
        acc[ai][bj][m][n] = __builtin_amdgcn_mfma_f32_16x16x32_bf16(Bt[n][k], At[m][k], acc[ai][bj][m][n], 0, 0, 0); __builtin_amdgcn_s_setprio(0); } while (0)
#define PG8_WAIT_V(n) asm volatile("s_waitcnt vmcnt(" #n ")" ::: "memory")
#define PG8_WAIT_L(n) asm volatile("s_waitcnt lgkmcnt(" #n ")" ::: "memory")
#define PG8_BAR __builtin_amdgcn_s_barrier()
#define PG8_SCHED __builtin_amdgcn_sched_barrier(0)
    Unit cur, nxt; int ui = 0;
    if (!S.next(0, cur)) return;
    f32x4 acc[2][2][4][2];
#pragma unroll
    for (int a = 0; a < 2; ++a)
#pragma unroll
        for (int b = 0; b < 2; ++b)
#pragma unroll
            for (int m = 0; m < 4; ++m)
#pragma unroll
                for (int n = 0; n < 2; ++n) acc[a][b][m][n] = (f32x4){0.f, 0.f, 0.f, 0.f};
    bf16x8 At[4][2], B0[2][2], B1[2][2];
    const char* cA = (const char*)g.A + (size_t)cur.pm * tstep; const char* cB = (const char*)g.Bt + (size_t)cur.pn * tstep;
    S.a_ready(cur);
    if constexpr (SP2) {
        PG8_STAGE(PG8_SB(0, 0), cB, voffB); PG8_STAGE(PG8_SB(0, 1), cB + hstep, voffB); PG8_STAGE(PG8_SA(0, 0), cA, voffA); PG8_STAGE(PG8_SA(0, 1), cA + hstep, voffA);
        if (wr == 1) PG8_BAR;
        PG8_WAIT_V(2); PG8_BAR;
        PG8_STAGE(PG8_SB(1, 0), cB + kstep, voffB); PG8_STAGE(PG8_SA(1, 0), cA + kstep, voffA); PG8_STAGE(PG8_SB(1, 1), cB + hstep + kstep, voffB);
        PG8_WAIT_V(6); PG8_BAR;
    } else {
        PG8_STAGE(PG8_SB(0, 0), cB, voffB); PG8_STAGE(PG8_SA(0, 0), cA, voffA); PG8_STAGE(PG8_SB(0, 1), cB + hstep, voffB); PG8_STAGE(PG8_SA(0, 1), cA + hstep, voffA);
        if (wr == 1) PG8_BAR;
        PG8_WAIT_V(4); PG8_BAR;
        PG8_STAGE(PG8_SB(1, 0), cB + kstep, voffB); PG8_STAGE(PG8_SA(1, 0), cA + kstep, voffA); PG8_STAGE(PG8_SB(1, 1), cB + hstep + kstep, voffB);
        PG8_WAIT_V(6); PG8_BAR;
    }
    for (;;) {
        const bool has_next = S.next(ui + 1, nxt);
        const char* nA = has_next ? (const char*)g.A + (size_t)nxt.pm * tstep : cA; const char* nB = has_next ? (const char*)g.Bt + (size_t)nxt.pn * tstep : cB;
        for (int t = 0; t < nt; t += 2) {
            const bool last = (t == nt - 2);
            const char* a1 = cA + (size_t)(t + 1) * kstep;
            const char* a2 = last ? nA : cA + (size_t)(t + 2) * kstep; const char* b2 = last ? nB : cB + (size_t)(t + 2) * kstep;
            const char* a3 = a2 + kstep; const char* b3 = b2 + kstep;
            if (last && has_next) S.a_ready(nxt);
            if constexpr (Epi::MIDK) { if (t == (nt >> 1)) E.mid(acc, cur, wr, wc, fr, fq); }
            if constexpr (SP2) {
            PG8_LDB(B0, 0, 0); PG8_LDB(B1, 0, 1); PG8_SCHED; PG8_LDA(At, 0, 0); PG8_STAGE(PG8_SA(1, 1), a1 + hstep, voffA);
            PG8_WAIT_V(8); PG8_WAIT_L(0); PG8_BAR; PG8_MMA(0, 0, At, B0); PG8_MMA(0, 1, At, B1); PG8_BAR; PG8_SCHED;
            PG8_LDA(At, 0, 1); PG8_STAGE(PG8_SB(0, 0), b2, voffB); PG8_STAGE(PG8_SB(0, 1), b2 + hstep, voffB); PG8_STAGE(PG8_SA(0, 0), a2, voffA);
            PG8_WAIT_V(8); PG8_WAIT_L(0); PG8_BAR; PG8_MMA(1, 0, At, B0); PG8_MMA(1, 1, At, B1); PG8_BAR; PG8_SCHED;
            PG8_LDB(B0, 1, 0); PG8_LDB(B1, 1, 1); PG8_SCHED; PG8_LDA(At, 1, 0); PG8_STAGE(PG8_SA(0, 1), a2 + hstep, voffA);
            PG8_WAIT_V(8); PG8_WAIT_L(0); PG8_BAR; PG8_MMA(0, 0, At, B0); PG8_MMA(0, 1, At, B1); PG8_BAR; PG8_SCHED;
            PG8_LDA(At, 1, 1); PG8_STAGE(PG8_SB(1, 0), b3, voffB); PG8_STAGE(PG8_SB(1, 1), b3 + hstep, voffB); PG8_STAGE(PG8_SA(1, 0), a3, voffA);
            PG8_WAIT_V(8); PG8_WAIT_L(0); PG8_BAR; PG8_MMA(1, 0, At, B0); PG8_MMA(1, 1, At, B1); PG8_BAR; PG8_SCHED;
            } else {
            PG8_LDB(B0, 0, 0); PG8_SCHED; PG8_LDA(At, 0, 0); PG8_STAGE(PG8_SA(1, 1), a1 + hstep, voffA);
            PG8_WAIT_L(8); PG8_BAR; PG8_WAIT_L(0); PG8_MMA(0, 0, At, B0); PG8_BAR; PG8_SCHED;
            PG8_LDB(B1, 0, 1); PG8_STAGE(PG8_SB(0, 0), b2, voffB);
            PG8_BAR; PG8_WAIT_L(0); PG8_MMA(0, 1, At, B1); PG8_BAR;
            PG8_LDA(At, 0, 1); PG8_STAGE(PG8_SA(0, 0), a2, voffA);
            PG8_BAR; PG8_WAIT_L(0); PG8_MMA(1, 0, At, B0); PG8_BAR; PG8_SCHED;
            PG8_STAGE(PG8_SB(0, 1), b2 + hstep, voffB);
            PG8_WAIT_V(6); PG8_BAR; PG8_MMA(1, 1, At, B1); PG8_BAR;
            PG8_LDB(B0, 1, 0); PG8_SCHED; PG8_LDA(At, 1, 0); PG8_STAGE(PG8_SA(0, 1), a2 + hstep, voffA);
            PG8_WAIT_L(8); PG8_BAR; PG8_WAIT_L(0); PG8_MMA(0, 0, At, B0); PG8_BAR; PG8_SCHED;
            PG8_LDB(B1, 1, 1); PG8_STAGE(PG8_SB(1, 0), b3, voffB);
            PG8_BAR; PG8_WAIT_L(0); PG8_MMA(0, 1, At, B1); PG8_BAR;
            PG8_LDA(At, 1, 1); PG8_STAGE(PG8_SA(1, 0), a3, voffA);
            PG8_BAR; PG8_WAIT_L(0); PG8_MMA(1, 0, At, B0); PG8_BAR; PG8_SCHED;
            PG8_STAGE(PG8_SB(1, 1), b3 + hstep, voffB);
            PG8_WAIT_V(6); PG8_BAR; PG8_MMA(1, 1, At, B1); PG8_BAR;
            }
        }
        if constexpr (ALIGN_EPI) { if (wr == 0) PG8_BAR; }
        if constexpr (!Epi::AFTER_DRAIN) { E(acc, cur, wr, wc, fr, fq); S.done(cur); }
        if (!has_next) break;
#pragma unroll
        for (int a = 0; a < 2; ++a)
#pragma unroll
            for (int b = 0; b < 2; ++b)
#pragma unroll
                for (int m = 0; m < 4; ++m)
#pragma unroll
                    for (int n = 0; n < 2; ++n) acc[a][b][m][n] = (f32x4){0.f, 0.f, 0.f, 0.f};
        cur = nxt; cA = nA; cB = nB; ++ui;
        if constexpr (ALIGN_EPI) { if (wr == 1) PG8_BAR; }
    }
    PG8_WAIT_V(0);
    if constexpr (!ALIGN_EPI) { if (wr == 0) PG8_BAR; }
    PG8_BAR;
    if constexpr (Epi::AFTER_DRAIN) { E.fused(acc, cur, wr, wc, fr, fq, lds, wid, lane); S.done(cur); }
#undef PG8_SA
#undef PG8_SB
#undef PG8_STAGE
#undef PG8_LDA
#undef PG8_LDB
#undef PG8_MMA
#undef PG8_WAIT_V
#undef PG8_WAIT_L
#undef PG8_BAR
#undef PG8_SCHED
}
}
using pg8::bf16_t; using pg8::bf16x8; using pg8::f32x4; using pg8::u32x4; using pg8::cvt_pk_bf16; using pg8::bf_lo; using pg8::bf_hi; using pg8::pack8; using pg8::sigmoid_f;
constexpr int SEQ = 4096, NB = 4, DM = 1024, MTOK = NB * SEQ, DIN = 6144, DFF = 4096, NCHUNK = 32;
constexpr size_t MiB = 1u << 20;
constexpr size_t WS_WIN = 0, WS_WOA = 12 * MiB, WS_WOB = 14 * MiB, WS_WOUT = 16 * MiB, WS_WUP = 18 * MiB, WS_WDN = 26 * MiB, WS_WG = 34 * MiB, WS_WSM = 35 * MiB;
constexpr size_t WS_SUMA = 35 * MiB + 512 * 1024, WS_SUMB = 36 * MiB, WS_LNST = 36 * MiB + 512 * 1024, WS_SS1 = WS_LNST + 128 * 1024, WS_SS2 = WS_SS1 + 64 * 1024;
constexpr size_t WS_Z4 = 38 * MiB;
constexpr size_t WS_TMP = WS_Z4, WS_MRG = WS_Z4 + 64 * MiB, WS_U = WS_Z4;
constexpr size_t WS_XN = 166 * MiB;
constexpr size_t WS_YA = WS_XN, WS_H1B = WS_XN, WS_YB = 198 * MiB, WS_END = 230 * MiB;
constexpr size_t WS_BAR = 37 * MiB;
constexpr int LDS_BYTES = 144 * 1024;

struct Params { const float* in[21]; float* out; unsigned char* ws; };

typedef float f32x2 __attribute__((ext_vector_type(2)));
__device__ __forceinline__ float wave_sum(float v) {
#pragma unroll
    for (int o = 1; o < 64; o <<= 1) v += __shfl_xor(v, o);
    return v;
}
__device__ __forceinline__ void tr_item(const float* __restrict__ W, int N, int K, bf16_t* __restrict__ WT, const float* __restrict__ ks, float* scr, int item, int lane, int ldk = 0) {
    if (ldk == 0) ldk = K;
    const int nblk = N / 32, kb = item / nblk, nb = item % nblk, k0 = 64 * kb, n0 = 32 * nb;
#pragma unroll 8
    for (int i = 0; i < 32; ++i) { const int kk = 2 * i + (lane >> 5); scr[kk * 33 + (lane & 31)] = W[(size_t)(k0 + kk) * N + n0 + (lane & 31)]; }
    asm volatile("s_waitcnt lgkmcnt(0)" ::: "memory");
    const int c = lane & 7;
    f32x4 s0 = {1.f, 1.f, 1.f, 1.f}, s1 = {1.f, 1.f, 1.f, 1.f};
    if (ks) { s0 = *(const f32x4*)(ks + k0 + 8 * c); s1 = *(const f32x4*)(ks + k0 + 8 * c + 4); }
#pragma unroll
    for (int j = 0; j < 4; ++j) { const int n = (lane >> 3) + 8 * j; const float* s = scr + (8 * c) * 33 + n;
        u32x4 o; o.x = cvt_pk_bf16(s[0 * 33] * s0[0], s[1 * 33] * s0[1]); o.y = cvt_pk_bf16(s[2 * 33] * s0[2], s[3 * 33] * s0[3]); o.z = cvt_pk_bf16(s[4 * 33] * s1[0], s[5 * 33] * s1[1]); o.w = cvt_pk_bf16(s[6 * 33] * s1[2], s[7 * 33] * s1[3]);
        *(u32x4*)(WT + (size_t)(n0 + n) * ldk + k0 + 8 * c) = o; }
    asm volatile("s_waitcnt lgkmcnt(0)" ::: "memory");
}
__device__ __forceinline__ void rms_row_to_bf16(const float* __restrict__ xrow, const float* __restrict__ g, bf16_t* __restrict__ orow, int lane) {
    const f32x4* xr = (const f32x4*)xrow + lane; const f32x4* gr = (const f32x4*)g + lane;
    f32x4 v[4]; float s = 0.f;
#pragma unroll
    for (int j = 0; j < 4; ++j) { v[j] = xr[64 * j]; s += (v[j][0] * v[j][0] + v[j][1] * v[j][1]) + (v[j][2] * v[j][2] + v[j][3] * v[j][3]); }
    const float rs = 1.0f / sqrtf(wave_sum(s) * (1.0f / 1024.0f) + 1e-6f);
    unsigned long long* o8 = (unsigned long long*)orow + lane;
#pragma unroll
    for (int j = 0; j < 4; ++j) { const f32x4 gg = gr[64 * j]; const f32x4 y = v[j] * rs * gg;
        o8[64 * j] = (unsigned long long)cvt_pk_bf16(y[0], y[1]) | ((unsigned long long)cvt_pk_bf16(y[2], y[3]) << 32); }
}
__device__ __forceinline__ void rms_rows2_to_bf16(const float* __restrict__ xa, const float* __restrict__ xb, const float* __restrict__ g, bf16_t* __restrict__ oa, bf16_t* __restrict__ ob, int lane) {
    const f32x4* ra = (const f32x4*)xa + lane; const f32x4* rb = (const f32x4*)xb + lane; const f32x4* gr = (const f32x4*)g + lane;
    f32x4 va[4], vb[4], gg[4]; float sa = 0.f, sb = 0.f;
#pragma unroll
    for (int j = 0; j < 4; ++j) { va[j] = ra[64 * j]; vb[j] = rb[64 * j]; gg[j] = gr[64 * j]; }
#pragma unroll
    for (int j = 0; j < 4; ++j) { sa += (va[j][0] * va[j][0] + va[j][1] * va[j][1]) + (va[j][2] * va[j][2] + va[j][3] * va[j][3]); sb += (vb[j][0] * vb[j][0] + vb[j][1] * vb[j][1]) + (vb[j][2] * vb[j][2] + vb[j][3] * vb[j][3]); }
#pragma unroll
    for (int o = 1; o < 64; o <<= 1) { sa += __shfl_xor(sa, o); sb += __shfl_xor(sb, o); }
    const float rsa = 1.0f / sqrtf(sa * (1.0f / 1024.0f) + 1e-6f), rsb = 1.0f / sqrtf(sb * (1.0f / 1024.0f) + 1e-6f);
    unsigned long long* pa = (unsigned long long*)oa + lane; unsigned long long* pb = (unsigned long long*)ob + lane;
#pragma unroll
    for (int j = 0; j < 4; ++j) { const f32x4 ya = va[j] * rsa * gg[j], yb = vb[j] * rsb * gg[j];
        pa[64 * j] = (unsigned long long)cvt_pk_bf16(ya[0], ya[1]) | ((unsigned long long)cvt_pk_bf16(ya[2], ya[3]) << 32);
        pb[64 * j] = (unsigned long long)cvt_pk_bf16(yb[0], yb[1]) | ((unsigned long long)cvt_pk_bf16(yb[2], yb[3]) << 32); }
}
__device__ __forceinline__ void unpack8(const u32x4 w, float (&f)[8]) { f[0] = bf_lo(w.x); f[1] = bf_hi(w.x); f[2] = bf_lo(w.y); f[3] = bf_hi(w.y); f[4] = bf_lo(w.z); f[5] = bf_hi(w.z); f[6] = bf_lo(w.w); f[7] = bf_hi(w.w); }
__device__ __forceinline__ float bf16_to_f(bf16_t h) { return __uint_as_float(((unsigned)h) << 16); }
__device__ __forceinline__ bf16_t f_to_bf16(float f) { return (bf16_t)(cvt_pk_bf16(f, 0.f) & 0xffffu); }

struct Ctx {
    const float* in[21]; float* out; unsigned char* ws;
    bf16_t *WIN, *WOA, *WOB, *WOUT, *WUP, *WDN, *WG, *WSM, *Z4, *ZG, *XN, *YA, *YB, *MRG, *H1B, *U;
    float *SUMA, *SUMB, *LNST, *SS1, *SS2, *TMP; unsigned* MASK;
};

constexpr int XC_LD = 264;
__device__ __forceinline__ void mixer_a_tile(unsigned char* lds, const Ctx& C, int tile) {
    int tid_ = threadIdx.x; asm volatile("" : "+v"(tid_));
    const int tid = tid_, lane = tid & 63, wave = tid >> 6, fr = lane & 15, fq = lane >> 4;
    const int h = tile & 3, ck = (tile >> 2) & 31, b = tile >> 7;
    const size_t row_base = (size_t)b * SEQ + (size_t)ck * 128;
    bf16_t* XC = (bf16_t*)lds;
    bf16_t* HB = (bf16_t*)(lds + 67584);
    float* H0 = (float*)(lds + 135168);
    const bf16_t* wgr = C.WG + ((size_t)(h * 2 + 0) * 256 + 32 * wave + fr) * 256 + 8 * fq;
    bf16x8 gf[4][4];
#pragma unroll
    for (int k = 0; k < 3; ++k) { gf[k][0] = *(const bf16x8*)(wgr + k * 32); gf[k][1] = *(const bf16x8*)(wgr + 4096 + k * 32); gf[k][2] = *(const bf16x8*)(wgr + 65536 + k * 32); gf[k][3] = *(const bf16x8*)(wgr + 65536 + 4096 + k * 32); }
    {
        const int cc = tid & 31, tg = tid >> 5, ch0 = h * 256 + cc * 8;
        const float* cw = C.in[3]; const float* cbp = C.in[4];
        float w[4][8], cb[8];
#pragma unroll
        for (int k = 0; k < 4; ++k) { const f32x4 w0 = *(const f32x4*)(cw + k * DM + ch0), w1 = *(const f32x4*)(cw + k * DM + ch0 + 4);
#pragma unroll
            for (int j = 0; j < 4; ++j) { w[k][j] = w0[j]; w[k][4 + j] = w1[j]; } }
        { const f32x4 b0 = *(const f32x4*)(cbp + ch0), b1 = *(const f32x4*)(cbp + ch0 + 4);
#pragma unroll
          for (int j = 0; j < 4; ++j) { cb[j] = b0[j]; cb[4 + j] = b1[j]; } }
        u32x4 xr[11];
#pragma unroll
        for (int tt = 0; tt < 11; ++tt) { const int tl = tg * 8 - 3 + tt; const int tglob = ck * 128 + tl;
            xr[tt] = (tglob >= 0) ? *(const u32x4*)(C.Z4 + ((size_t)b * SEQ + tglob) * 4096 + ch0) : (u32x4){0u, 0u, 0u, 0u}; }
#pragma unroll
        for (int t = 0; t < 8; ++t) { float o[8];
#pragma unroll
            for (int j = 0; j < 8; ++j) o[j] = cb[j];
#pragma unroll
            for (int k = 0; k < 4; ++k) { float x[8]; unpack8(xr[t + 3 - k], x);
#pragma unroll
                for (int j = 0; j < 8; ++j) o[j] += w[k][j] * x[j]; }
            u32x4 pk; pk.x = cvt_pk_bf16(o[0], o[1]); pk.y = cvt_pk_bf16(o[2], o[3]); pk.z = cvt_pk_bf16(o[4], o[5]); pk.w = cvt_pk_bf16(o[6], o[7]);
            *(u32x4*)(XC + (tg * 8 + t) * XC_LD + cc * 8) = pk; }
    }
    __syncthreads();
    f32x4 accr[2][8], acci[2][8];
#pragma unroll
    for (int n = 0; n < 2; ++n)
#pragma unroll
        for (int m = 0; m < 8; ++m) { accr[n][m] = (f32x4){0.f, 0.f, 0.f, 0.f}; acci[n][m] = (f32x4){0.f, 0.f, 0.f, 0.f}; }
    {
        const bf16_t* xa = XC + fr * XC_LD + 8 * fq;
#pragma unroll
        for (int ks = 0; ks < 8; ++ks) {
            if (ks + 3 < 8) { const bf16_t* wn = wgr + (ks + 3) * 32; bf16x8* d = gf[(ks + 3) % 4];
                d[0] = *(const bf16x8*)(wn); d[1] = *(const bf16x8*)(wn + 4096); d[2] = *(const bf16x8*)(wn + 65536); d[3] = *(const bf16x8*)(wn + 65536 + 4096); }
            const bf16x8* cf = gf[ks % 4];
#pragma unroll
            for (int m = 0; m < 8; ++m) { const bf16x8 a = *(const bf16x8*)(xa + m * 16 * XC_LD + ks * 32);
                accr[0][m] = __builtin_amdgcn_mfma_f32_16x16x32_bf16(a, cf[0], accr[0][m], 0, 0, 0);
                accr[1][m] = __builtin_amdgcn_mfma_f32_16x16x32_bf16(a, cf[1], accr[1][m], 0, 0, 0);
                acci[0][m] = __builtin_amdgcn_mfma_f32_16x16x32_bf16(a, cf[2], acci[0][m], 0, 0, 0);
                acci[1][m] = __builtin_amdgcn_mfma_f32_16x16x32_bf16(a, cf[3], acci[1][m], 0, 0, 0); }
            asm volatile("" ::: "memory");
        }
    }
#pragma unroll
    for (int n = 0; n < 2; ++n) {
        const int chl = 32 * wave + 16 * n + fr, ch = h * 256 + chl;
        const float brv = C.in[6][ch], biv = C.in[8][ch], lam = C.in[9][ch];
        const float sp8 = -8.0f * (fmaxf(-lam, 0.f) + log1pf(__expf(-fabsf(lam))));
        const float sp8l2 = sp8 * 1.4426950409f, sp16 = 2.0f * sp8; const float nbr = -1.4426950409f * brv, nbi = -1.4426950409f * biv;
        float hc = 0.f, Ac = 1.f;
#pragma unroll
        for (int m = 0; m < 8; ++m) {
            float a[4], bx[4];
#pragma unroll
            for (int hh = 0; hh < 2; ++hh) {
                const int t = 16 * m + 4 * fq + 2 * hh;
                const f32x2 xcv = {bf16_to_f(XC[t * XC_LD + chl]), bf16_to_f(XC[(t + 1) * XC_LD + chl])};
                const f32x2 pr = {accr[n][m][2 * hh], accr[n][m][2 * hh + 1]}, pi = {acci[n][m][2 * hh], acci[n][m][2 * hh + 1]};
                f32x2 xr = pr * (-1.4426950409f) + nbr, xi = pi * (-1.4426950409f) + nbi;
                xr.x = fminf(xr.x, 60.f); xr.y = fminf(xr.y, 60.f); xi.x = fminf(xi.x, 60.f); xi.y = fminf(xi.y, 60.f);
                f32x2 er, ei; er.x = __builtin_amdgcn_exp2f(xr.x); er.y = __builtin_amdgcn_exp2f(xr.y); ei.x = __builtin_amdgcn_exp2f(xi.x); ei.y = __builtin_amdgcn_exp2f(xi.y);
                const f32x2 dr = er + 1.0f, di = ei + 1.0f, dd = dr * di;
                f32x2 inv; inv.x = __builtin_amdgcn_rcpf(dd.x); inv.y = __builtin_amdgcn_rcpf(dd.y);
                const f32x2 r = di * inv, ig = dr * inv;
                const f32x2 l2 = r * sp8l2;
                f32x2 av; av.x = __builtin_amdgcn_exp2f(l2.x); av.y = __builtin_amdgcn_exp2f(l2.y);
                const f32x2 x2 = r * sp16;
                f32x2 q = x2 * 0.0013888889f + 0.0083333338f; q = q * x2 + 0.041666668f; q = q * x2 + 0.16666667f; q = q * x2 + 0.5f; q = q * x2 + 1.0f;
                const f32x2 ser = -x2 * q, dir = 1.0f - av * av;
                f32x2 m2; m2.x = fmaxf((x2.x > -0.25f) ? ser.x : dir.x, 0.f); m2.y = fmaxf((x2.y > -0.25f) ? ser.y : dir.y, 0.f);
                f32x2 mu; mu.x = __builtin_amdgcn_sqrtf(m2.x); mu.y = __builtin_amdgcn_sqrtf(m2.y);
                const f32x2 bxx = xcv * ig * mu;
                a[2 * hh] = av.x; a[2 * hh + 1] = av.y; bx[2 * hh] = bxx.x; bx[2 * hh + 1] = bxx.y;
            }
            const float p0 = a[0], h0l = bx[0];
            const float p1 = p0 * a[1], h1l = h0l * a[1] + bx[1];
            const float p2 = p1 * a[2], h2l = h1l * a[2] + bx[2];
            const float p3 = p2 * a[3], h3l = h2l * a[3] + bx[3];
            float Ai = p3, Bi = h3l;
            float At = __shfl_up(Ai, 16), Bt = __shfl_up(Bi, 16);
            if (fq >= 1) { Bi = Bt * Ai + Bi; Ai = At * Ai; }
            At = __shfl_up(Ai, 32); Bt = __shfl_up(Bi, 32);
            if (fq >= 2) { Bi = Bt * Ai + Bi; Ai = At * Ai; }
            const float Am = __shfl(Ai, 48 + fr), Bm = __shfl(Bi, 48 + fr);
            float Ae = __shfl_up(Ai, 16), Be = __shfl_up(Bi, 16);
            if (fq == 0) { Ae = 1.f; Be = 0.f; }
            const float hin = Be + Ae * hc, Pin = Ae * Ac;
            accr[n][m] = (f32x4){Pin * p0, Pin * p1, Pin * p2, Pin * p3};
            acci[n][m] = (f32x4){h0l + p0 * hin, h1l + p1 * hin, h2l + p2 * hin, h3l + p3 * hin};
            hc = hc * Am + Bm; Ac *= Am;
        }
        if (fq == 0) { const size_t o = ((size_t)(b * NCHUNK + ck)) * DM + ch;
            __hip_atomic_store(C.SUMA + o, Ac, __ATOMIC_RELAXED, __HIP_MEMORY_SCOPE_AGENT); __hip_atomic_store(C.SUMB + o, hc, __ATOMIC_RELAXED, __HIP_MEMORY_SCOPE_AGENT); }
    }
    asm volatile("s_waitcnt vmcnt(0)" ::: "memory");
    __syncthreads();
    if (tid == 0) {
        unsigned* mk = C.MASK + 64 * (b * 4 + h);
        __hip_atomic_fetch_or(mk, 1u << ck, __ATOMIC_RELAXED, __HIP_MEMORY_SCOPE_AGENT);
        const unsigned need = (1u << ck) - 1u; unsigned sp = 0u;
        while ((__hip_atomic_load(mk, __ATOMIC_RELAXED, __HIP_MEMORY_SCOPE_AGENT) & need) != need) { __builtin_amdgcn_s_sleep(1); if (++sp > (1u << 22)) break; }
        __builtin_amdgcn_fence(__ATOMIC_ACQUIRE, "agent");
        asm volatile("s_waitcnt vmcnt(0)" ::: "memory");
    }
    __syncthreads();
    if (tid < 256) {
        const int ch = h * 256 + tid; float hcar = 0.f;
        for (int c2 = 0; c2 < ck; c2 += 8) { float a[8], bb[8];
#pragma unroll
            for (int j = 0; j < 8; ++j) { const bool ok = (c2 + j) < ck; const size_t o = ((size_t)(b * NCHUNK + (ok ? c2 + j : 0))) * DM + ch;
                a[j] = ok ? __hip_atomic_load(C.SUMA + o, __ATOMIC_RELAXED, __HIP_MEMORY_SCOPE_AGENT) : 1.f; bb[j] = ok ? __hip_atomic_load(C.SUMB + o, __ATOMIC_RELAXED, __HIP_MEMORY_SCOPE_AGENT) : 0.f; }
#pragma unroll
            for (int j = 0; j < 8; ++j) hcar = hcar * a[j] + bb[j]; }
        H0[tid] = hcar;
    }
    __syncthreads();
#pragma unroll
    for (int n = 0; n < 2; ++n) { const int chl = 32 * wave + 16 * n + fr; const float h0 = H0[chl];
#pragma unroll
        for (int m = 0; m < 8; ++m)
#pragma unroll
            for (int i = 0; i < 4; ++i) HB[(16 * m + 4 * fq + i) * XC_LD + chl] = f_to_bf16(acci[n][m][i] + accr[n][m][i] * h0); }
    __syncthreads();
    {
        const int cc = tid & 31, tg = tid >> 5;
#pragma unroll
        for (int t4 = 0; t4 < 8; t4 += 4) {
        u32x4 gav[4];
#pragma unroll
        for (int tt = 0; tt < 4; ++tt) gav[tt] = *(const u32x4*)(C.Z4 + (row_base + tg * 8 + t4 + tt) * 4096 + 1024 + h * 256 + cc * 8);
#pragma unroll
        for (int tt = 0; tt < 4; ++tt) { const int t = tg * 8 + t4 + tt;
            float hv[8], gv[8]; unpack8(*(const u32x4*)(HB + t * XC_LD + cc * 8), hv); unpack8(gav[tt], gv);
            u32x4 pk; pk.x = cvt_pk_bf16(hv[0] * gv[0], hv[1] * gv[1]); pk.y = cvt_pk_bf16(hv[2] * gv[2], hv[3] * gv[3]); pk.z = cvt_pk_bf16(hv[4] * gv[4], hv[5] * gv[5]); pk.w = cvt_pk_bf16(hv[6] * gv[6], hv[7] * gv[7]);
            *(u32x4*)(C.YA + (row_base + t) * 2048 + h * 256 + cc * 8) = pk; }
        asm volatile("" ::: "memory"); }
    }
    __syncthreads();
}

constexpr int WS_LD = 136;
__device__ __forceinline__ void mixer_b_tile(unsigned char* lds, const Ctx& C, int tile) {
    int tid_ = threadIdx.x; asm volatile("" : "+v"(tid_));
    const int tid = tid_, lane = tid & 63, wave = tid >> 6, fr = lane & 15, fq = lane >> 4;
    const int g = tile & 3, ck = (tile >> 2) & 31, b = tile >> 7;
    const size_t row_base = (size_t)b * SEQ + (size_t)ck * 128;
    bf16_t* WSL = (bf16_t*)lds;
    bf16_t* VT = (bf16_t*)(lds + 34816);
    bf16_t* SB = VT;
#pragma unroll
    for (int j = 0; j < 4; ++j) { const int q = tid + 512 * j, t = q >> 4, s8 = q & 15;
        *(u32x4*)(WSL + t * WS_LD + s8 * 8) = *(const u32x4*)(C.WSM + (size_t)g * 16384 + t * 128 + s8 * 8); }
    {
        const int wv = __builtin_amdgcn_readfirstlane(wave);
        u32x4 vv[4][2];
#pragma unroll
        for (int q = 0; q < 4; ++q) { const int ch = g * 256 + (4 * wv + q) * 8;
            vv[q][0] = *(const u32x4*)(C.Z4 + (row_base + 2 * lane) * 4096 + 3072 + ch); vv[q][1] = *(const u32x4*)(C.Z4 + (row_base + 2 * lane + 1) * 4096 + 3072 + ch); }
        f32x4 st = *(const f32x4*)(C.LNST + (row_base + 2 * lane) * 2);
        { const float m0 = st[0] * (1.0f / 1024.0f), m1 = st[2] * (1.0f / 1024.0f);
          st[1] = __builtin_amdgcn_rsqf(fmaxf(st[1] * (1.0f / 1024.0f) - m0 * m0, 0.f) + 1e-5f); st[3] = __builtin_amdgcn_rsqf(fmaxf(st[3] * (1.0f / 1024.0f) - m1 * m1, 0.f) + 1e-5f); st[0] = m0; st[2] = m1; }
#pragma unroll
        for (int q = 0; q < 4; ++q) { const int chl = (4 * wv + q) * 8, ch = g * 256 + chl;
            float v0[8], v1[8]; unpack8(vv[q][0], v0); unpack8(vv[q][1], v1);
            float lg[8], lb[8];
            { const f32x4 a0 = *(const f32x4*)(C.in[11] + ch), a1 = *(const f32x4*)(C.in[11] + ch + 4), b0 = *(const f32x4*)(C.in[12] + ch), b1 = *(const f32x4*)(C.in[12] + ch + 4);
#pragma unroll
              for (int j = 0; j < 4; ++j) { lg[j] = a0[j]; lg[4 + j] = a1[j]; lb[j] = b0[j]; lb[4 + j] = b1[j]; } }
#pragma unroll
            for (int j = 0; j < 8; ++j) { const float y0 = (v0[j] - st[0]) * st[1] * lg[j] + lb[j], y1 = (v1[j] - st[2]) * st[3] * lg[j] + lb[j];
                *(unsigned*)(VT + (chl + j) * WS_LD + 2 * lane) = cvt_pk_bf16(y0, y1); }
        }
    }
    __syncthreads();
    f32x4 acc[2][8];
#pragma unroll
    for (int n = 0; n < 2; ++n)
#pragma unroll
        for (int m = 0; m < 8; ++m) acc[n][m] = (f32x4){0.f, 0.f, 0.f, 0.f};
#pragma unroll
    for (int ks = 0; ks < 4; ++ks) {
        const bf16x8 b0 = *(const bf16x8*)(VT + (32 * wave + fr) * WS_LD + 32 * ks + 8 * fq), b1 = *(const bf16x8*)(VT + (32 * wave + 16 + fr) * WS_LD + 32 * ks + 8 * fq);
#pragma unroll
        for (int m = 0; m < 8; ++m) if (m >= 2 * ks) { const bf16x8 a = *(const bf16x8*)(WSL + (16 * m + fr) * WS_LD + 32 * ks + 8 * fq);
            acc[0][m] = __builtin_amdgcn_mfma_f32_16x16x32_bf16(a, b0, acc[0][m], 0, 0, 0);
            acc[1][m] = __builtin_amdgcn_mfma_f32_16x16x32_bf16(a, b1, acc[1][m], 0, 0, 0); }
    }
    __syncthreads();
    {
        const float* bs = C.in[14] + g * 128;
#pragma unroll
        for (int m = 0; m < 8; ++m) { const f32x4 bv = *(const f32x4*)(bs + 16 * m + 4 * fq);
#pragma unroll
            for (int n = 0; n < 2; ++n)
#pragma unroll
                for (int i = 0; i < 4; ++i) SB[(16 * m + 4 * fq + i) * XC_LD + 32 * wave + 16 * n + fr] = f_to_bf16(acc[n][m][i] + bv[i]); }
    }
    __syncthreads();
    {
        const int cc = tid & 31, tg = tid >> 5;
#pragma unroll
        for (int t4 = 0; t4 < 8; t4 += 4) {
        u32x4 uvv[4];
#pragma unroll
        for (int tt = 0; tt < 4; ++tt) uvv[tt] = *(const u32x4*)(C.Z4 + (row_base + tg * 8 + t4 + tt) * 4096 + 2048 + g * 256 + cc * 8);
#pragma unroll
        for (int tt = 0; tt < 4; ++tt) { const int t = tg * 8 + t4 + tt;
            float sv[8], uv[8]; unpack8(*(const u32x4*)(SB + t * XC_LD + cc * 8), sv); unpack8(uvv[tt], uv);
            u32x4 pk; pk.x = cvt_pk_bf16(sv[0] * uv[0], sv[1] * uv[1]); pk.y = cvt_pk_bf16(sv[2] * uv[2], sv[3] * uv[3]); pk.z = cvt_pk_bf16(sv[4] * uv[4], sv[5] * uv[5]); pk.w = cvt_pk_bf16(sv[6] * uv[6], sv[7] * uv[7]);
            *(u32x4*)(C.YA + (row_base + t) * 2048 + 1024 + g * 256 + cc * 8) = pk; }
        asm volatile("" ::: "memory"); }
    }
    __syncthreads();
}

#define LAS __attribute__((address_space(3)))
#define XB_TMO      128
#define XB_XCNT(j)  (256  + 64 * (j))
#define XB_XSUB(j)  (1280 + 64 * (j))
#define XB_XGEN(j)  (2304 + 64 * (j))
#define XB_TOP      3328
#define XB_TOPGEN   3392
#define XCD_BAR_WORDS 3456
#define XB_SPIN_CAP (1u << 18)

__device__ __forceinline__ unsigned xb_ld(unsigned* p)              { return __hip_atomic_load(p, __ATOMIC_RELAXED, __HIP_MEMORY_SCOPE_AGENT); }
__device__ __forceinline__ unsigned xb_add(unsigned* p, unsigned v) { return __hip_atomic_fetch_add(p, v, __ATOMIC_RELAXED, __HIP_MEMORY_SCOPE_AGENT); }
__device__ __forceinline__ unsigned xb_xcc_id() { return (unsigned)__builtin_amdgcn_s_getreg((3 << 11) | 20) & 0xFu; }
#define XB_SPIN(cond, bar) do { unsigned _sp = 0; while (cond) { __builtin_amdgcn_s_sleep(1); \
    if ((++_sp & 255u) == 0u) { if (xb_ld(&(bar)[XB_TMO])) break; if (_sp > XB_SPIN_CAP) { atomicAdd(&(bar)[XB_TMO], 1u); break; } } } } while (0)

struct XcdBarrier {
    unsigned* bar; unsigned x;
    volatile LAS unsigned* st;
};

__device__ __forceinline__ XcdBarrier xcd_barrier_post(unsigned* bar, volatile LAS unsigned* st) {
    XcdBarrier b; b.bar = bar; b.x = xb_xcc_id(); b.st = st;
    if (threadIdx.x == 0) (void)xb_add(&bar[XB_XCNT(b.x)], 1u);
    return b;
}
__device__ __forceinline__ void xcd_barrier_complete(unsigned* bar, unsigned x, unsigned& nloc, unsigned& nx) {
    const unsigned G = gridDim.x * gridDim.y * gridDim.z;
    unsigned sum, cnt, mine, sp = 0u;
    for (;;) {
        sum = 0u; cnt = 0u; mine = 0u;
#pragma unroll
        for (unsigned j = 0; j < 16; ++j) { const unsigned c = xb_ld(&bar[XB_XCNT(j)]); sum += c; cnt += (c > 0u) ? 1u : 0u; mine = (j == x) ? c : mine; }
        if (sum == G) break;
        __builtin_amdgcn_s_sleep(1);
        if ((++sp & 255u) == 0u) { if (xb_ld(&bar[XB_TMO])) break; if (sp > XB_SPIN_CAP) { atomicAdd(&bar[XB_TMO], 1u); break; } }
    }
    nloc = mine > 0u ? mine : 1u; nx = cnt > 0u ? cnt : 1u;
}

__device__ __forceinline__ void xcd_barrier(const XcdBarrier& b) {
    asm volatile("s_waitcnt vmcnt(0)" ::: "memory");
    __syncthreads();
    if (threadIdx.x == 0) {
        unsigned* bar = b.bar;
        __builtin_amdgcn_s_waitcnt(0);
        unsigned nloc = b.st[0], nx = b.st[1];
        if (nloc == 0u) { xcd_barrier_complete(bar, b.x, nloc, nx); b.st[0] = nloc; b.st[1] = nx; }
        const unsigned old = xb_add(&bar[XB_XSUB(b.x)], 1u);
        const unsigned gen = old / nloc;
        if (old + 1u == (gen + 1u) * nloc) {
            __builtin_amdgcn_fence(__ATOMIC_RELEASE, "agent");
            asm volatile("s_waitcnt vmcnt(0)" ::: "memory");
            const unsigned og = xb_add(&bar[XB_TOP], 1u);
            const unsigned tg = og / nx;
            if (og + 1u == (tg + 1u) * nx) xb_add(&bar[XB_TOPGEN], 1u);
            else XB_SPIN(xb_ld(&bar[XB_TOPGEN]) == tg, bar);
            __builtin_amdgcn_fence(__ATOMIC_ACQUIRE, "agent");
            xb_add(&bar[XB_XGEN(b.x)], 1u);
            asm volatile("s_waitcnt vmcnt(0)" ::: "memory");
        } else {
            XB_SPIN(xb_ld(&bar[XB_XGEN(b.x)]) == gen, bar);
            __builtin_amdgcn_fence(__ATOMIC_ACQUIRE, "agent");
            asm volatile("s_waitcnt vmcnt(0)" ::: "memory");
        }
    }
    __syncthreads();
}
__global__ void __launch_bounds__(512, 2) hybrid_fwd(Params P) {
    extern __shared__ __attribute__((aligned(16))) unsigned char lds[];
    cg::grid_group grid = cg::this_grid();
    const int G = gridDim.x, NGW = G * 8;
    Ctx C;
#pragma unroll
    for (int i = 0; i < 21; ++i) C.in[i] = P.in[i];
    C.out = P.out; C.ws = P.ws;
    unsigned char* ws = P.ws;
    C.WIN = (bf16_t*)(ws + WS_WIN); C.WOA = (bf16_t*)(ws + WS_WOA); C.WOB = (bf16_t*)(ws + WS_WOB); C.WOUT = (bf16_t*)(ws + WS_WOUT); C.WUP = (bf16_t*)(ws + WS_WUP); C.WDN = (bf16_t*)(ws + WS_WDN);
    C.WG = (bf16_t*)(ws + WS_WG); C.WSM = (bf16_t*)(ws + WS_WSM); C.Z4 = (bf16_t*)(ws + WS_Z4); C.ZG = (bf16_t*)P.out; C.XN = (bf16_t*)(ws + WS_XN + 1 * MiB + 8192); C.YA = (bf16_t*)(ws + WS_YA); C.YB = (bf16_t*)(ws + WS_YB);
    C.MRG = (bf16_t*)(ws + WS_MRG); C.H1B = (bf16_t*)(ws + WS_H1B); C.U = (bf16_t*)(ws + WS_U);
    C.SUMA = (float*)(ws + WS_SUMA); C.SUMB = (float*)(ws + WS_SUMB); C.LNST = (float*)(ws + WS_LNST); C.SS1 = (float*)(ws + WS_SS1); C.SS2 = (float*)(ws + WS_SS2); C.TMP = (float*)(ws + WS_TMP); C.MASK = (unsigned*)(ws + WS_BAR) + 4096;
    PG8_LAS unsigned char* ldsl = (PG8_LAS unsigned char*)lds;
    volatile LAS unsigned* bst = (volatile LAS unsigned*)(ldsl + LDS_BYTES - 16);
    if (threadIdx.x < 4) bst[threadIdx.x] = 0u;
    __syncthreads();
    const XcdBarrier bar = xcd_barrier_post((unsigned*)(ws + WS_BAR), bst);
    if (G > 65535) grid.sync();
#define GRID_BAR() xcd_barrier(bar)

    {
        int t0_ = threadIdx.x; asm volatile("" : "+v"(t0_)); const int tid = t0_, lane = tid & 63, wave = tid >> 6, gw = blockIdx.x * 8 + wave;
        float* scr = (float*)(lds + wave * 8448);
        constexpr int I_IN = 16 * 192, I_SQ = 16 * 32, I_UP = 16 * 128, I_DN = 64 * 32, I_G = 4 * 8;
        constexpr int NITEMS = I_IN + 3 * I_SQ + I_UP + I_DN + 8 * I_G;
        for (int it = gw; it < NITEMS; it += NGW) {
            int r = it;
            if (r < I_IN) { tr_item(C.in[2], DIN, DM, C.WIN, nullptr, scr, r, lane); continue; } r -= I_IN;
            if (r < I_SQ) { tr_item(C.in[10], DM, DM, C.WOA, nullptr, scr, r, lane, 2048); continue; } r -= I_SQ;
            if (r < I_SQ) { tr_item(C.in[15], DM, DM, C.WOA + 1024, nullptr, scr, r, lane, 2048); continue; } r -= I_SQ;
            if (r < I_SQ) { tr_item(C.in[16], DM, DM, C.WOUT, nullptr, scr, r, lane); continue; } r -= I_SQ;
            if (r < I_UP) { tr_item(C.in[18], DFF, DM, C.WUP, C.in[17], scr, r, lane); continue; } r -= I_UP;
            if (r < I_DN) { tr_item(C.in[19], DM, DFF, C.WDN, nullptr, scr, r, lane); continue; } r -= I_DN;
            { const int mat = r / I_G, item = r % I_G, hh = mat >> 1, gate = mat & 1;
              tr_item(C.in[gate ? 7 : 5] + (size_t)hh * 65536, 256, 256, C.WG + (size_t)(hh * 2 + gate) * 65536, nullptr, scr, item, lane); }
        }
        for (int i = blockIdx.x * 512 + tid; i < 4 * 128 * 128; i += G * 512) { const int t = (i >> 7) & 127, s = i & 127; C.WSM[i] = (s <= t) ? pg8::cvt_pk_bf16(C.in[13][i], 0.f) & 0xffffu : 0; }
        for (int i = blockIdx.x * 512 + tid; i < MTOK; i += G * 512) { C.SS1[i] = 0.f; C.SS2[i] = 0.f; C.LNST[2 * i] = 0.f; C.LNST[2 * i + 1] = 0.f; }
        for (int m = gw; m < MTOK; m += 2 * NGW) {
            const int m2 = m + NGW;
            if (m2 < MTOK) rms_rows2_to_bf16(C.in[0] + (size_t)m * DM, C.in[0] + (size_t)m2 * DM, C.in[1], C.XN + (size_t)m * DM, C.XN + (size_t)m2 * DM, lane);
            else rms_row_to_bf16(C.in[0] + (size_t)m * DM, C.in[1], C.XN + (size_t)m * DM, lane);
        }
    }
    GRID_BAR();
    { pg8::Gemm g{C.XN, C.WIN, MTOK, DIN, DM}; pg8::StaticOrder S; S.init(MTOK, DIN, G, (int)blockIdx.x, (blockIdx.x & 1) ? 2 : 0);
      pg8::EpiZ E{C.Z4, C.ZG, C.LNST};
      pg8::gemm_phase<pg8::EpiZ, pg8::StaticOrder, true, true>(ldsl, g, S, E); }
    GRID_BAR();
    if (blockIdx.x & 2) for (int t = blockIdx.x; t < 512; t += G) mixer_b_tile(lds, C, t);
    for (int t = blockIdx.x; t < 512; t += G) mixer_a_tile(lds, C, t);
    if (!(blockIdx.x & 2)) for (int t = blockIdx.x; t < 512; t += G) mixer_b_tile(lds, C, t);
    GRID_BAR();
    { pg8::Gemm g{C.YA, C.WOA, MTOK, DM, 2 * DM}; pg8::StaticOrder S; S.init(MTOK, DM, G, (int)blockIdx.x);
      pg8::EpiMerge2 E{(const unsigned char*)C.ZG, C.MRG};
      pg8::gemm_phase<pg8::EpiMerge2, pg8::StaticOrder, true, true>(ldsl, g, S, E); }
    GRID_BAR();
    { pg8::Gemm g{C.MRG, C.WOUT, MTOK, DM, DM}; pg8::StaticOrder S; S.init(MTOK, DM, G, (int)blockIdx.x);
      pg8::EpiH1 E{C.in[0], C.out, C.H1B, C.SS1, G == 256 ? 0 : 1};
      pg8::gemm_phase<pg8::EpiH1, pg8::StaticOrder, true, true>(ldsl, g, S, E); }
    GRID_BAR();
    { pg8::Gemm g{C.H1B, C.WUP, MTOK, DFF, DM}; pg8::StaticOrder S; S.init(MTOK, DFF, G, (int)blockIdx.x);
      pg8::EpiUp E{C.SS1, C.U};
      pg8::gemm_phase<pg8::EpiUp, pg8::StaticOrder, true, true>(ldsl, g, S, E); }
    GRID_BAR();
    if (G == 256) {
      pg8::Gemm g{C.U, C.WDN, MTOK, DM, DFF}; pg8::StaticOrder S; S.init(MTOK, DM, G, (int)blockIdx.x);
      pg8::EpiDownNorm E{C.H1B, C.out, C.SS2, C.MASK + 1024, C.in[20]};
      pg8::gemm_phase<pg8::EpiDownNorm, pg8::StaticOrder, false, true>(ldsl, g, S, E);
    } else {
      { pg8::Gemm g{C.U, C.WDN, MTOK, DM, DFF}; pg8::StaticOrder S; S.init(MTOK, DM, G, (int)blockIdx.x);
        pg8::EpiDown E{C.out, C.SS2};
        pg8::gemm_phase<pg8::EpiDown, pg8::StaticOrder, true, true>(ldsl, g, S, E); }
      GRID_BAR();
      int t8_ = threadIdx.x; asm volatile("" : "+v"(t8_)); const int lane = t8_ & 63, gw = blockIdx.x * 8 + (t8_ >> 6);
      for (int m = gw; m < MTOK; m += NGW) {
        f32x4* xr = (f32x4*)(C.out + (size_t)m * DM) + lane; const f32x4* gr = (const f32x4*)C.in[20] + lane;
        const float rs = 1.0f / sqrtf(C.SS2[m] * (1.0f / 1024.0f) + 1e-6f);
#pragma unroll
        for (int j = 0; j < 4; ++j) xr[64 * j] = xr[64 * j] * rs * gr[64 * j];
      }
    }
}

extern "C" void kernel_launch(void* const* d_in, const int* in_sizes, int n_in, void* d_out, int out_size, void* d_ws, size_t ws_size, hipStream_t stream) {
    static int grid_blocks = 0;
    if (grid_blocks == 0) {
        if (n_in != 21 || out_size != MTOK * DM || ws_size < WS_END) { fprintf(stderr, "kernel_launch: unexpected shapes (n_in %d, out %d, ws %zu)\n", n_in, out_size, ws_size); grid_blocks = -1; return; }
        int dev = 0, cus = 0, per_cu = 0;
        hipGetDevice(&dev); hipDeviceGetAttribute(&cus, hipDeviceAttributeMultiprocessorCount, dev);
        if (hipFuncSetAttribute((const void*)hybrid_fwd, hipFuncAttributeMaxDynamicSharedMemorySize, LDS_BYTES) != hipSuccess) fprintf(stderr, "kernel_launch: hipFuncSetAttribute failed\n");
        if (hipOccupancyMaxActiveBlocksPerMultiprocessor(&per_cu, (const void*)hybrid_fwd, 512, LDS_BYTES) != hipSuccess || per_cu < 1) { fprintf(stderr, "kernel_launch: occupancy query says %d\n", per_cu); per_cu = 1; }
        (void)hipGetLastError();
        grid_blocks = cus * 1;
    }
    if (grid_blocks < 0) return;
    Params p{};
    for (int i = 0; i < 21; ++i) p.in[i] = (const float*)d_in[i];
    p.out = (float*)d_out; p.ws = (unsigned char*)d_ws;
    if (hipMemsetAsync((char*)d_ws + WS_BAR, 0, (4096 + 1024 + 64 * 64) * sizeof(unsigned), stream) != hipSuccess) { fprintf(stderr, "kernel_launch: memset failed\n"); return; }
    void* args[] = {&p};
    hipError_t e = hipLaunchCooperativeKernel((const void*)hybrid_fwd, dim3(grid_blocks), dim3(512), args, LDS_BYTES, stream);
    if (e != hipSuccess) fprintf(stderr, "cooperative launch failed: %s (grid %d)\n", hipGetErrorString(e), grid_blocks);
}
```

```cpp
#include <hip/hip_runtime.h>
#include <hip/hip_cooperative_groups.h>
#include <cstdio>
#include <cstdint>
namespace cg = cooperative_groups;
namespace pg8 {
#define PG8_LAS __attribute__((address_space(3)))
typedef unsigned short bf16_t;
typedef short bf16x8 __attribute__((ext_vector_type(8)));
typedef float f32x4 __attribute__((ext_vector_type(4)));
typedef unsigned u32x4 __attribute__((ext_vector_type(4)));
constexpr int BM = 256, BK = 64, HALF = 128, HTB = HALF * BK * 2  , STAGE_BYTES = 8 * HTB, NXCD = 8, WGM = 8;

__host__ __device__ __forceinline__ int lds_byte(int r, int c) { const int st = (r >> 4) * 2 + (c >> 5), rr = r & 15, cc = c & 31, ob = rr * 64 + cc * 2; return st * 1024 + (ob ^ (((ob >> 9) & 1) << 5)); }
__host__ __device__ __forceinline__ void stage_rc(int b, int& R, int& C) { const int st = b / 1024, sb = b % 1024, swz = sb ^ (((sb >> 9) & 1) << 5); R = (st >> 1) * 16 + swz / 64; C = (st & 1) * 32 + (swz % 64) / 2; }
__host__ __device__ __forceinline__ int perm32(int rho) { const int n = rho >> 4, i = rho & 15; return 8 * (i >> 2) + 4 * n + (i & 3); }

struct Unit { int pm, pn; };
struct Gemm { const bf16_t* A; const bf16_t* Bt; int M, N, K; };

struct StaticOrder {
    int nM, nN, nwg, G, c, rot, nround;
    __host__ __device__ void init(int M, int N, int G_, int c_, int rot_ = 0) { nM = M / BM; nN = N / BM; nwg = nM * nN; G = G_; c = c_; nround = nwg / G; rot = (nwg % G == 0 && nround > 1) ? rot_ % nround : 0; }
    __host__ __device__ bool next(int i, Unit& u) const {
        if ((long)i * G + c >= nwg) return false;
        int ii = i + rot; if (rot && ii >= nround) ii -= nround;
        const long L = (long)ii * G + c;
        int wgid = (int)L; { const int q = nwg / NXCD, r = nwg % NXCD, xcd = wgid % NXCD, off = wgid / NXCD; wgid = (xcd < r ? xcd * (q + 1) : r * (q + 1) + (xcd - r) * q) + off; }
        const int nig = WGM * nN, gid = wgid / nig, fm = gid * WGM, gsz = (nM - fm) < WGM ? (nM - fm) : WGM;
        u.pm = fm + ((wgid % nig) % gsz); u.pn = (wgid % nig) / gsz; return true;
    }
    __device__ __forceinline__ void a_ready(const Unit&) const {}
    __device__ __forceinline__ void done(const Unit&) const {}
};

__device__ __forceinline__ unsigned cvt_pk_bf16(float lo, float hi) { unsigned r; asm volatile("v_cvt_pk_bf16_f32 %0, %1, %2" : "=v"(r) : "v"(lo), "v"(hi)); return r; }
__device__ __forceinline__ float sigmoid_f(float x) { return __builtin_amdgcn_rcpf(1.0f + __builtin_amdgcn_exp2f(-1.4426950409f * x)); }
__device__ __forceinline__ float gelu_tanh_f(float x) { const float t = x * (1.5957691216f + 0.0713548163f * x * x); return x * __builtin_amdgcn_rcpf(1.0f + __builtin_amdgcn_exp2f(-1.4426950409f * t)); }
typedef float f32x2e __attribute__((ext_vector_type(2)));
__device__ __forceinline__ f32x2e gelu_tanh_pk(f32x2e x) { const f32x2e x2 = x * x; const f32x2e t = x * (x2 * (-0.1029432407f) + (-2.3022081925f));
    f32x2e e; e.x = __builtin_amdgcn_exp2f(t.x); e.y = __builtin_amdgcn_exp2f(t.y); const f32x2e d = e + 1.0f; f32x2e r; r.x = __builtin_amdgcn_rcpf(d.x); r.y = __builtin_amdgcn_rcpf(d.y); return x * r; }
__device__ __forceinline__ f32x2e sigmoid_pk(f32x2e x) { const f32x2e t = x * (-1.4426950409f); f32x2e e; e.x = __builtin_amdgcn_exp2f(t.x); e.y = __builtin_amdgcn_exp2f(t.y); const f32x2e d = e + 1.0f;
    f32x2e r; r.x = __builtin_amdgcn_rcpf(d.x); r.y = __builtin_amdgcn_rcpf(d.y); return r; }
__device__ __forceinline__ float bf_lo(unsigned w) { return __uint_as_float(w << 16); }
__device__ __forceinline__ float bf_hi(unsigned w) { return __uint_as_float(w & 0xffff0000u); }
__device__ __forceinline__ u32x4 pack8(const f32x4 v0, const f32x4 v1) { u32x4 w; w.x = cvt_pk_bf16(v0[0], v0[1]); w.y = cvt_pk_bf16(v0[2], v0[3]); w.z = cvt_pk_bf16(v1[0], v1[1]); w.w = cvt_pk_bf16(v1[2], v1[3]); return w; }

struct EpiZ {
    static constexpr bool PERM = true, AFTER_DRAIN = false, MIDK = false;
    bf16_t* Z4; bf16_t* ZG; float* LNS;
    template <int MODE> __device__ __forceinline__ void body(const f32x4 (&acc)[2][2][4][2], int pn, int row0, int wc, int fq) const {
        typedef unsigned u32x2v __attribute__((ext_vector_type(2)));
        const int col0 = (MODE == 3 ? (pn - 16) * BM : pn * BM) + wc * 32 + 8 * fq;
#pragma unroll
        for (int ai = 0; ai < 2; ++ai)
#pragma unroll
            for (int m = 0; m < 4; ++m) { const size_t row = (size_t)(row0 + ai * HALF + m * 16); float s = 0.f, q = 0.f;
#pragma unroll
                for (int bj = 0; bj < 2; ++bj) { f32x4 v0 = acc[ai][bj][m][0], v1 = acc[ai][bj][m][1];
                    if (MODE == 3) {
                        unsigned w0 = 0u, w1 = 0u;
#pragma unroll
                        for (int j = 0; j < 4; j += 2) { const f32x2e s0 = sigmoid_pk((f32x2e){v0[j], v0[j + 1]}) * 255.0f, s1 = sigmoid_pk((f32x2e){v1[j], v1[j + 1]}) * 255.0f;
                            w0 = __builtin_amdgcn_cvt_pk_u8_f32(fmaxf(__builtin_rintf(s0.x), 1.0f), j, w0); w0 = __builtin_amdgcn_cvt_pk_u8_f32(fmaxf(__builtin_rintf(s0.y), 1.0f), j + 1, w0);
                            w1 = __builtin_amdgcn_cvt_pk_u8_f32(fmaxf(__builtin_rintf(s1.x), 1.0f), j, w1); w1 = __builtin_amdgcn_cvt_pk_u8_f32(fmaxf(__builtin_rintf(s1.y), 1.0f), j + 1, w1); }
                        *(u32x2v*)((unsigned char*)ZG + row * 2048 + col0 + bj * HALF) = (u32x2v){w0, w1};
                    } else {
                        if (MODE >= 1) {
#pragma unroll
                            for (int j = 0; j < 4; j += 2) { const f32x2e a = gelu_tanh_pk((f32x2e){v0[j], v0[j + 1]}), b = gelu_tanh_pk((f32x2e){v1[j], v1[j + 1]}); v0[j] = a.x; v0[j + 1] = a.y; v1[j] = b.x; v1[j + 1] = b.y; } }
                        if (MODE == 2) { s += (v0[0] + v0[1]) + (v0[2] + v0[3]) + (v1[0] + v1[1]) + (v1[2] + v1[3]);
                            q += (v0[0] * v0[0] + v0[1] * v0[1]) + (v0[2] * v0[2] + v0[3] * v0[3]) + (v1[0] * v1[0] + v1[1] * v1[1]) + (v1[2] * v1[2] + v1[3] * v1[3]); }
                        *(u32x4*)(Z4 + row * 4096 + col0 + bj * HALF) = pack8(v0, v1); } }
                if (MODE == 2) { s += __shfl_xor(s, 16); s += __shfl_xor(s, 32); q += __shfl_xor(q, 16); q += __shfl_xor(q, 32);
                    if (fq == 0) { float* p = LNS + row * 2; __hip_atomic_fetch_add(p, s, __ATOMIC_RELAXED, __HIP_MEMORY_SCOPE_AGENT); __hip_atomic_fetch_add(p + 1, q, __ATOMIC_RELAXED, __HIP_MEMORY_SCOPE_AGENT); } } }
    }
    __device__ __forceinline__ void operator()(const f32x4 (&acc)[2][2][4][2], const Unit& u, int wr, int wc, int fr, int fq) const {
        const int sec = u.pn >> 2, row0 = u.pm * BM + wr * 64 + fr;
        if (sec == 0) body<0>(acc, u.pn, row0, wc, fq);
        else if (sec < 3) body<1>(acc, u.pn, row0, wc, fq);
        else if (sec == 3) body<2>(acc, u.pn, row0, wc, fq);
        else body<3>(acc, u.pn, row0, wc, fq);
    }
};
struct EpiMerge2 {
    static constexpr bool PERM = true, AFTER_DRAIN = false, MIDK = true;
    const unsigned char* G; bf16_t* O;
    typedef unsigned u32x2v __attribute__((ext_vector_type(2)));
    static __device__ __forceinline__ f32x4 ub4(unsigned w) { return (f32x4){(float)(w & 0xffu), (float)((w >> 8) & 0xffu), (float)((w >> 16) & 0xffu), (float)(w >> 24)}; }
    __device__ __forceinline__ void mid(f32x4 (&acc)[2][2][4][2], const Unit& u, int wr, int wc, int fr, int fq) const {
        int row0 = u.pm * BM + wr * 64 + fr, col0 = u.pn * BM + wc * 32 + 8 * fq;
        asm volatile("" : "+v"(row0), "+v"(col0));
#pragma unroll
        for (int ai = 0; ai < 2; ++ai)
#pragma unroll
            for (int m = 0; m < 4; ++m) { const unsigned char* gp = G + (size_t)(row0 + ai * HALF + m * 16) * 2048 + col0;
#pragma unroll
                for (int bj = 0; bj < 2; ++bj) { const u32x2v a = *(const u32x2v*)(gp + bj * HALF), b = *(const u32x2v*)(gp + 1024 + bj * HALF);
                    const f32x4 a0 = ub4(a.x), a1 = ub4(a.y), b0 = ub4(b.x), b1 = ub4(b.y);
#pragma unroll
                    for (int j = 0; j < 4; ++j) { acc[ai][bj][m][0][j] *= a0[j] * __builtin_amdgcn_rcpf(b0[j]); acc[ai][bj][m][1][j] *= a1[j] * __builtin_amdgcn_rcpf(b1[j]); }
                    asm volatile("" ::: "memory"); } }
    }
    __device__ __forceinline__ void operator()(const f32x4 (&acc)[2][2][4][2], const Unit& u, int wr, int wc, int fr, int fq) const {
        const int row0 = u.pm * BM + wr * 64 + fr, col0 = u.pn * BM + wc * 32 + 8 * fq;
        u32x2v gbv[2][4][2];
#pragma unroll
        for (int ai = 0; ai < 2; ++ai)
#pragma unroll
            for (int m = 0; m < 4; ++m)
#pragma unroll
                for (int bj = 0; bj < 2; ++bj) gbv[ai][m][bj] = *(const u32x2v*)(G + (size_t)(row0 + ai * HALF + m * 16) * 2048 + 1024 + col0 + bj * HALF);
#pragma unroll
        for (int ai = 0; ai < 2; ++ai)
#pragma unroll
            for (int m = 0; m < 4; ++m) { const size_t row = (size_t)(row0 + ai * HALF + m * 16);
#pragma unroll
                for (int bj = 0; bj < 2; ++bj) { const int c = col0 + bj * HALF; const u32x2v b = gbv[ai][m][bj];
                    const f32x4 b0 = ub4(b.x) * (1.0f / 255.0f), b1 = ub4(b.y) * (1.0f / 255.0f);
                    *(u32x4*)(O + row * 1024 + c) = pack8(acc[ai][bj][m][0] * b0, acc[ai][bj][m][1] * b1); } }
    }
};
struct EpiH1 {
    static constexpr bool PERM = true, AFTER_DRAIN = false, MIDK = false;
    const float* X; float* H; bf16_t* HB; float* SS; int wH;
    template <bool WH> __device__ __forceinline__ void body(const f32x4 (&acc)[2][2][4][2], const Unit& u, int wr, int wc, int fr, int fq) const {
        const int row0 = u.pm * BM + wr * 64 + fr, col0 = u.pn * BM + wc * 32 + 8 * fq;
#pragma unroll
        for (int ai = 0; ai < 2; ++ai)
#pragma unroll
          for (int mh = 0; mh < 4; mh += 2) {
            f32x4 xv[2][2][2];
#pragma unroll
            for (int m = 0; m < 2; ++m)
#pragma unroll
                for (int bj = 0; bj < 2; ++bj) { const float* xp = X + (size_t)(row0 + ai * HALF + (mh + m) * 16) * 1024 + col0 + bj * HALF; xv[m][bj][0] = *(const f32x4*)xp; xv[m][bj][1] = *(const f32x4*)(xp + 4); }
#pragma unroll
            for (int m = 0; m < 2; ++m) { const size_t row = (size_t)(row0 + ai * HALF + (mh + m) * 16); float s = 0.f;
#pragma unroll
                for (int bj = 0; bj < 2; ++bj) { const int c = col0 + bj * HALF;
                    const f32x4 v0 = xv[m][bj][0] + acc[ai][bj][mh + m][0], v1 = xv[m][bj][1] + acc[ai][bj][mh + m][1];
                    if (WH) { *(f32x4*)(H + row * 1024 + c) = v0; *(f32x4*)(H + row * 1024 + c + 4) = v1; }
                    *(u32x4*)(HB + row * 1024 + c) = pack8(v0, v1);
                    s += (v0[0] * v0[0] + v0[1] * v0[1]) + (v0[2] * v0[2] + v0[3] * v0[3]) + (v1[0] * v1[0] + v1[1] * v1[1]) + (v1[2] * v1[2] + v1[3] * v1[3]); }
                s += __shfl_xor(s, 16); s += __shfl_xor(s, 32);
                if (fq == 0) __hip_atomic_fetch_add(SS + row, s, __ATOMIC_RELAXED, __HIP_MEMORY_SCOPE_AGENT); }
            asm volatile("" ::: "memory");
          }
    }
    __device__ __forceinline__ void operator()(const f32x4 (&acc)[2][2][4][2], const Unit& u, int wr, int wc, int fr, int fq) const {
        if (wH) body<true>(acc, u, wr, wc, fr, fq); else body<false>(acc, u, wr, wc, fr, fq);
    }
};
struct EpiUp {
    static constexpr bool PERM = true, AFTER_DRAIN = false, MIDK = false;
    const float* SS; bf16_t* U;
    __device__ __forceinline__ void operator()(const f32x4 (&acc)[2][2][4][2], const Unit& u, int wr, int wc, int fr, int fq) const {
        const int row0 = u.pm * BM + wr * 64 + fr, col0 = u.pn * BM + wc * 32 + 8 * fq;
        float ssv[2][4];
#pragma unroll
        for (int ai = 0; ai < 2; ++ai)
#pragma unroll
            for (int m = 0; m < 4; ++m) ssv[ai][m] = SS[row0 + ai * HALF + m * 16];
#pragma unroll
        for (int ai = 0; ai < 2; ++ai)
#pragma unroll
            for (int m = 0; m < 4; ++m) { const size_t row = (size_t)(row0 + ai * HALF + m * 16);
                const float rs = __builtin_amdgcn_rsqf(ssv[ai][m] * (1.0f / 1024.0f) + 1e-6f);
#pragma unroll
                for (int bj = 0; bj < 2; ++bj) { f32x4 v0 = acc[ai][bj][m][0] * rs, v1 = acc[ai][bj][m][1] * rs;
#pragma unroll
                    for (int j = 0; j < 4; ++j) { const float a = fmaxf(v0[j], 0.f), b = fmaxf(v1[j], 0.f); v0[j] = a * a; v1[j] = b * b; }
                    *(u32x4*)(U + row * 4096 + col0 + bj * HALF) = pack8(v0, v1); } }
    }
};
struct EpiDown {
    static constexpr bool PERM = false, AFTER_DRAIN = false, MIDK = false;
    float* H; float* SS;
    __device__ __forceinline__ void operator()(const f32x4 (&acc)[2][2][4][2], const Unit& u, int wr, int wc, int fr, int fq) const {
        const int row0 = u.pm * BM + wr * 64 + fr, col0 = u.pn * BM + wc * 32 + 4 * fq;
#pragma unroll
        for (int ai = 0; ai < 2; ++ai)
#pragma unroll
            for (int m = 0; m < 4; ++m) { const size_t row = (size_t)(row0 + ai * HALF + m * 16); float s = 0.f;
#pragma unroll
                for (int bj = 0; bj < 2; ++bj)
#pragma unroll
                    for (int n = 0; n < 2; ++n) { float* p = H + row * 1024 + col0 + bj * HALF + n * 16; const f32x4 v = *(const f32x4*)p + acc[ai][bj][m][n]; *(f32x4*)p = v;
                        s += (v[0] * v[0] + v[1] * v[1]) + (v[2] * v[2] + v[3] * v[3]); }
                s += __shfl_xor(s, 16); s += __shfl_xor(s, 32);
                if (fq == 0) __hip_atomic_fetch_add(SS + row, s, __ATOMIC_RELAXED, __HIP_MEMORY_SCOPE_AGENT); }
    }
};

struct EpiDownNorm {
    static constexpr bool PERM = true, AFTER_DRAIN = true, MIDK = false;
    const bf16_t* HB; float* OUT; float* SS; unsigned* CNT; const float* g;
    __device__ __forceinline__ void fused(f32x4 (&acc)[2][2][4][2], const Unit& u, int wr, int wc, int fr, int fq, PG8_LAS unsigned char* lds, int wid, int lane) const {
        const int row0 = u.pm * BM + wr * 64 + fr, col0 = u.pn * BM + wc * 32 + 8 * fq;
        u32x4 hbv[2][4][2];
#pragma unroll
        for (int ai = 0; ai < 2; ++ai)
#pragma unroll
            for (int m = 0; m < 4; ++m)
#pragma unroll
                for (int bj = 0; bj < 2; ++bj) hbv[ai][m][bj] = *(const u32x4*)(HB + (size_t)(row0 + ai * HALF + m * 16) * 1024 + col0 + bj * HALF);
        float old8[2][4];
#pragma unroll
        for (int ai = 0; ai < 2; ++ai)
#pragma unroll
            for (int m = 0; m < 4; ++m) { const size_t row = (size_t)(row0 + ai * HALF + m * 16); float s = 0.f;
#pragma unroll
                for (int bj = 0; bj < 2; ++bj) { const u32x4 hb = hbv[ai][m][bj];
                    const f32x4 v0 = (f32x4){bf_lo(hb.x), bf_hi(hb.x), bf_lo(hb.y), bf_hi(hb.y)} + acc[ai][bj][m][0], v1 = (f32x4){bf_lo(hb.z), bf_hi(hb.z), bf_lo(hb.w), bf_hi(hb.w)} + acc[ai][bj][m][1];
                    acc[ai][bj][m][0] = v0; acc[ai][bj][m][1] = v1;
                    s += (v0[0] * v0[0] + v0[1] * v0[1]) + (v0[2] * v0[2] + v0[3] * v0[3]) + (v1[0] * v1[0] + v1[1] * v1[1]) + (v1[2] * v1[2] + v1[3] * v1[3]); }
                s += __shfl_xor(s, 16); s += __shfl_xor(s, 32);
                old8[ai][m] = (fq == 0) ? __hip_atomic_fetch_add(SS + row, s, __ATOMIC_RELAXED, __HIP_MEMORY_SCOPE_AGENT) : 0.f; }
        asm volatile("s_waitcnt vmcnt(0)" :: "v"(old8[0][0]), "v"(old8[0][1]), "v"(old8[0][2]), "v"(old8[0][3]), "v"(old8[1][0]), "v"(old8[1][1]), "v"(old8[1][2]), "v"(old8[1][3]) : "memory");
        __syncthreads();
        if (threadIdx.x == 0) {
            unsigned* c = CNT + 64 * u.pm;
            __hip_atomic_fetch_add(c, 1u, __ATOMIC_RELAXED, __HIP_MEMORY_SCOPE_AGENT);
            unsigned sp = 0u;
            while (__hip_atomic_load(c, __ATOMIC_RELAXED, __HIP_MEMORY_SCOPE_AGENT) < 4u) { __builtin_amdgcn_s_sleep(1); if (++sp > (1u << 22)) break; }
            __builtin_amdgcn_fence(__ATOMIC_ACQUIRE, "agent");
            asm volatile("s_waitcnt vmcnt(0)" ::: "memory");
        }
        __syncthreads();
        f32x4 gv[2][2]; float ssv[2][4];
#pragma unroll
        for (int bj = 0; bj < 2; ++bj)
#pragma unroll
            for (int n = 0; n < 2; ++n) gv[bj][n] = *(const f32x4*)(g + col0 + bj * HALF + 4 * n);
#pragma unroll
        for (int ai = 0; ai < 2; ++ai)
#pragma unroll
            for (int m = 0; m < 4; ++m) ssv[ai][m] = __hip_atomic_load(SS + (size_t)(row0 + ai * HALF + m * 16), __ATOMIC_RELAXED, __HIP_MEMORY_SCOPE_AGENT);
#pragma unroll
        for (int ai = 0; ai < 2; ++ai)
#pragma unroll
            for (int m = 0; m < 4; ++m) { const size_t row = (size_t)(row0 + ai * HALF + m * 16);
                const float rs = __builtin_amdgcn_rsqf(ssv[ai][m] * (1.0f / 1024.0f) + 1e-6f);
#pragma unroll
                for (int bj = 0; bj < 2; ++bj)
#pragma unroll
                    for (int n = 0; n < 2; ++n) *(f32x4*)(OUT + row * 1024 + col0 + bj * HALF + 4 * n) = acc[ai][bj][m][n] * rs * gv[bj][n]; }
    }
};
template <class Epi, class Sched, bool ALIGN_EPI = false, bool SP2 = false>
__device__ __forceinline__ void gemm_phase(PG8_LAS unsigned char* lds, const Gemm g, const Sched& S, const Epi& E) {
    int tid_ = threadIdx.x; asm volatile("" : "+v"(tid_));
    const int tid = tid_, wid = __builtin_amdgcn_readfirstlane(tid >> 6), lane = tid & 63, wr = wid >> 2, wc = wid & 3, fr = lane & 15, fq = lane >> 4;
    const int K = g.K, nt = K / BK;
    unsigned voffA[2], voffB[2];
#pragma unroll
    for (int i = 0; i < 2; ++i) { int R, C; stage_rc(tid * 16 + i * 8192, R, C); const int Rb = Epi::PERM ? ((R & ~31) + perm32(R & 31)) : R;
        voffA[i] = (unsigned)(R * K + C) * 2u; voffB[i] = (unsigned)(Rb * K + C) * 2u; }
    const size_t kstep = (size_t)(BK * 2);
    const size_t hstep = (size_t)HALF * K * 2;
    const size_t tstep = 2 * hstep;
    const unsigned ldsw = (unsigned)wid * 1024u;
    const int aoff = lds_byte(wr * 64 + fr, fq * 8), boff = lds_byte(wc * 32 + fr, fq * 8);
#define PG8_SA(b, h) (((b) * 2 + (h)) * HTB)
#define PG8_SB(b, h) ((4 + (b) * 2 + (h)) * HTB)
#define PG8_STAGE(bufoff, gbase, voff) do { _Pragma("unroll") for (int _i = 0; _i < 2; ++_i) \
        __builtin_amdgcn_global_load_lds((const unsigned*)((const char*)(gbase) + (voff)[_i]), (PG8_LAS unsigned*)(lds + (bufoff) + ldsw + _i * 8192), 16, 0, 0); } while (0)
#define PG8_LDA(dst, b, h) do { _Pragma("unroll") for (int m = 0; m < 4; ++m) _Pragma("unroll") for (int k = 0; k < 2; ++k) dst[m][k] = *(const PG8_LAS bf16x8*)(lds + PG8_SA(b, h) + aoff + m * 2048 + k * 1024); } while (0)
#define PG8_LDB(dst, b, h) do { _Pragma("unroll") for (int n = 0; n < 2; ++n) _Pragma("unroll") for (int k = 0; k < 2; ++k) dst[n][k] = *(const PG8_LAS bf16x8*)(lds + PG8_SB(b, h) + boff + n * 2048 + k * 1024); } while (0)
#define PG8_MMA(ai, bj, At, Bt) do { __builtin_amdgcn_s_setprio(1); _Pragma("unroll") for (int m = 0; m < 4; ++m) _Pragma("unroll") for (int n = 0; n < 2; ++n) _Pragma("unroll") for (int k = 0; k < 2; ++k) \
        acc[ai][bj][m][n] = __builtin_amdgcn_mfma_f32_16x16x32_bf16(Bt[n][k], At[m][k], acc[ai][bj][m][n], 0, 0, 0); __builtin_amdgcn_s_setprio(0); } while (0)
#define PG8_WAIT_V(n) asm volatile("s_waitcnt vmcnt(" #n ")" ::: "memory")
#define PG8_WAIT_L(n) asm volatile("s_waitcnt lgkmcnt(" #n ")" ::: "memory")
#define PG8_BAR __builtin_amdgcn_s_barrier()
#define PG8_SCHED __builtin_amdgcn_sched_barrier(0)
    Unit cur, nxt; int ui = 0;
    if (!S.next(0, cur)) return;
    f32x4 acc[2][2][4][2];
#pragma unroll
    for (int a = 0; a < 2; ++a)
#pragma unroll
        for (int b = 0; b < 2; ++b)
#pragma unroll
            for (int m = 0; m < 4; ++m)
#pragma unroll
                for (int n = 0; n < 2; ++n) acc[a][b][m][n] = (f32x4){0.f, 0.f, 0.f, 0.f};
    bf16x8 At[4][2], B0[2][2], B1[2][2];
    const char* cA = (const char*)g.A + (size_t)cur.pm * tstep; const char* cB = (const char*)g.Bt + (size_t)cur.pn * tstep;
    S.a_ready(cur);
    if constexpr (SP2) {
        PG8_STAGE(PG8_SB(0, 0), cB, voffB); PG8_STAGE(PG8_SB(0, 1), cB + hstep, voffB); PG8_STAGE(PG8_SA(0, 0), cA, voffA); PG8_STAGE(PG8_SA(0, 1), cA + hstep, voffA);
        if (wr == 1) PG8_BAR;
        PG8_WAIT_V(2); PG8_BAR;
        PG8_STAGE(PG8_SB(1, 0), cB + kstep, voffB); PG8_STAGE(PG8_SA(1, 0), cA + kstep, voffA); PG8_STAGE(PG8_SB(1, 1), cB + hstep + kstep, voffB);
        PG8_WAIT_V(6); PG8_BAR;
    } else {
        PG8_STAGE(PG8_SB(0, 0), cB, voffB); PG8_STAGE(PG8_SA(0, 0), cA, voffA); PG8_STAGE(PG8_SB(0, 1), cB + hstep, voffB); PG8_STAGE(PG8_SA(0, 1), cA + hstep, voffA);
        if (wr == 1) PG8_BAR;
        PG8_WAIT_V(4); PG8_BAR;
        PG8_STAGE(PG8_SB(1, 0), cB + kstep, voffB); PG8_STAGE(PG8_SA(1, 0), cA + kstep, voffA); PG8_STAGE(PG8_SB(1, 1), cB + hstep + kstep, voffB);
        PG8_WAIT_V(6); PG8_BAR;
    }
    for (;;) {
        const bool has_next = S.next(ui + 1, nxt);
        const char* nA = has_next ? (const char*)g.A + (size_t)nxt.pm * tstep : cA; const char* nB = has_next ? (const char*)g.Bt + (size_t)nxt.pn * tstep : cB;
        for (int t = 0; t < nt; t += 2) {
            const bool last = (t == nt - 2);
            const char* a1 = cA + (size_t)(t + 1) * kstep;
            const char* a2 = last ? nA : cA + (size_t)(t + 2) * kstep; const char* b2 = last ? nB : cB + (size_t)(t + 2) * kstep;
            const char* a3 = a2 + kstep; const char* b3 = b2 + kstep;
            if (last && has_next) S.a_ready(nxt);
            if constexpr (Epi::MIDK) { if (t == (nt >> 1)) E.mid(acc, cur, wr, wc, fr, fq); }
            if constexpr (SP2) {
            PG8_LDB(B0, 0, 0); PG8_LDB(B1, 0, 1); PG8_SCHED; PG8_LDA(At, 0, 0); PG8_STAGE(PG8_SA(1, 1), a1 + hstep, voffA);
            PG8_WAIT_V(8); PG8_WAIT_L(0); PG8_BAR; PG8_MMA(0, 0, At, B0); PG8_MMA(0, 1, At, B1); PG8_BAR; PG8_SCHED;
            PG8_LDA(At, 0, 1); PG8_STAGE(PG8_SB(0, 0), b2, voffB); PG8_STAGE(PG8_SB(0, 1), b2 + hstep, voffB); PG8_STAGE(PG8_SA(0, 0), a2, voffA);
            PG8_WAIT_V(8); PG8_WAIT_L(0); PG8_BAR; PG8_MMA(1, 0, At, B0); PG8_MMA(1, 1, At, B1); PG8_BAR; PG8_SCHED;
            PG8_LDB(B0, 1, 0); PG8_LDB(B1, 1, 1); PG8_SCHED; PG8_LDA(At, 1, 0); PG8_STAGE(PG8_SA(0, 1), a2 + hstep, voffA);
            PG8_WAIT_V(8); PG8_WAIT_L(0); PG8_BAR; PG8_MMA(0, 0, At, B0); PG8_MMA(0, 1, At, B1); PG8_BAR; PG8_SCHED;
            PG8_LDA(At, 1, 1); PG8_STAGE(PG8_SB(1, 0), b3, voffB); PG8_STAGE(PG8_SB(1, 1), b3 + hstep, voffB); PG8_STAGE(PG8_SA(1, 0), a3, voffA);
            PG8_WAIT_V(8); PG8_WAIT_L(0); PG8_BAR; PG8_MMA(1, 0, At, B0); PG8_MMA(1, 1, At, B1); PG8_BAR; PG8_SCHED;
            } else {
            PG8_LDB(B0, 0, 0); PG8_SCHED; PG8_LDA(At, 0, 0); PG8_STAGE(PG8_SA(1, 1), a1 + hstep, voffA);
            PG8_WAIT_L(8); PG8_BAR; PG8_WAIT_L(0); PG8_MMA(0, 0, At, B0); PG8_BAR; PG8_SCHED;
            PG8_LDB(B1, 0, 1); PG8_STAGE(PG8_SB(0, 0), b2, voffB);
            PG8_BAR; PG8_WAIT_L(0); PG8_MMA(0, 1, At, B1); PG8_BAR;
            PG8_LDA(At, 0, 1); PG8_STAGE(PG8_SA(0, 0), a2, voffA);
            PG8_BAR; PG8_WAIT_L(0); PG8_MMA(1, 0, At, B0); PG8_BAR; PG8_SCHED;
            PG8_STAGE(PG8_SB(0, 1), b2 + hstep, voffB);
            PG8_WAIT_V(6); PG8_BAR; PG8_MMA(1, 1, At, B1); PG8_BAR;
            PG8_LDB(B0, 1, 0); PG8_SCHED; PG8_LDA(At, 1, 0); PG8_STAGE(PG8_SA(0, 1), a2 + hstep, voffA);
            PG8_WAIT_L(8); PG8_BAR; PG8_WAIT_L(0); PG8_MMA(0, 0, At, B0); PG8_BAR; PG8_SCHED;
            PG8_LDB(B1, 1, 1); PG8_STAGE(PG8_SB(1, 0), b3, voffB);
            PG8_BAR; PG8_WAIT_L(0); PG8_MMA(0, 1, At, B1); PG8_BAR;
            PG8_LDA(At, 1, 1); PG8_STAGE(PG8_SA(1, 0), a3, voffA);
            PG8_BAR; PG8_WAIT_L(0); PG8_MMA(1, 0, At, B0); PG8_BAR; PG8_SCHED;
            PG8_STAGE(PG8_SB(1, 1), b3 + hstep, voffB);
            PG8_WAIT_V(6); PG8_BAR; PG8_MMA(1, 1, At, B1); PG8_BAR;
            }
        }
        if constexpr (ALIGN_EPI) { if (wr == 0) PG8_BAR; }
        if constexpr (!Epi::AFTER_DRAIN) { E(acc, cur, wr, wc, fr, fq); S.done(cur); }
        if (!has_next) break;
#pragma unroll
        for (int a = 0; a < 2; ++a)
#pragma unroll
            for (int b = 0; b < 2; ++b)
#pragma unroll
                for (int m = 0; m < 4; ++m)
#pragma unroll
                    for (int n = 0; n < 2; ++n) acc[a][b][m][n] = (f32x4){0.f, 0.f, 0.f, 0.f};
        cur = nxt; cA = nA; cB = nB; ++ui;
        if constexpr (ALIGN_EPI) { if (wr == 1) PG8_BAR; }
    }
    PG8_WAIT_V(0);
    if constexpr (!ALIGN_EPI) { if (wr == 0) PG8_BAR; }
    PG8_BAR;
    if constexpr (Epi::AFTER_DRAIN) { E.fused(acc, cur, wr, wc, fr, fq, lds, wid, lane); S.done(cur); }
#undef PG8_SA
#undef PG8_SB
#undef PG8_STAGE
#undef PG8_LDA
#undef PG8_LDB
#undef PG8_MMA
#undef PG8_WAIT_V
#undef PG8_WAIT_L
#undef PG8_BAR
#undef PG8_SCHED
}
}
using pg8::bf16_t; using pg8::bf16x8; using pg8::f32x4; using pg8::u32x4; using pg8::cvt_pk_bf16; using pg8::bf_lo; using pg8::bf_hi; using pg8::pack8; using pg8::sigmoid_f;
constexpr int SEQ = 4096, NB = 4, DM = 1024, MTOK = NB * SEQ, DIN = 6144, DFF = 4096, NCHUNK = 32;
constexpr size_t MiB = 1u << 20;
constexpr size_t WS_WIN = 0, WS_WOA = 12 * MiB, WS_WOB = 14 * MiB, WS_WOUT = 16 * MiB, WS_WUP = 18 * MiB, WS_WDN = 26 * MiB, WS_WG = 34 * MiB, WS_WSM = 35 * MiB;
constexpr size_t WS_SUMA = 35 * MiB + 512 * 1024, WS_SUMB = 36 * MiB, WS_LNST = 36 * MiB + 512 * 1024, WS_SS1 = WS_LNST + 128 * 1024, WS_SS2 = WS_SS1 + 64 * 1024;
constexpr size_t WS_Z4 = 38 * MiB;
constexpr size_t WS_TMP = WS_Z4, WS_MRG = WS_Z4 + 64 * MiB, WS_U = WS_Z4;
constexpr size_t WS_XN = 166 * MiB;
constexpr size_t WS_YA = WS_XN, WS_H1B = WS_XN, WS_YB = 198 * MiB, WS_END = 230 * MiB;
constexpr size_t WS_BAR = 37 * MiB;
constexpr int LDS_BYTES = 144 * 1024;

struct Params { const float* in[21]; float* out; unsigned char* ws; };

typedef float f32x2 __attribute__((ext_vector_type(2)));
__device__ __forceinline__ float wave_sum(float v) {
#pragma unroll
    for (int o = 1; o < 64; o <<= 1) v += __shfl_xor(v, o);
    return v;
}
__device__ __forceinline__ void tr_item(const float* __restrict__ W, int N, int K, bf16_t* __restrict__ WT, const float* __restrict__ ks, float* scr, int item, int lane, int ldk = 0) {
    if (ldk == 0) ldk = K;
    const int nblk = N / 32, kb = item / nblk, nb = item % nblk, k0 = 64 * kb, n0 = 32 * nb;
#pragma unroll 8
    for (int i = 0; i < 32; ++i) { const int kk = 2 * i + (lane >> 5); scr[kk * 33 + (lane & 31)] = __builtin_nontemporal_load(W + (size_t)(k0 + kk) * N + n0 + (lane & 31)); }
    asm volatile("s_waitcnt lgkmcnt(0)" ::: "memory");
    const int c = lane & 7;
    f32x4 s0 = {1.f, 1.f, 1.f, 1.f}, s1 = {1.f, 1.f, 1.f, 1.f};
    if (ks) { s0 = *(const f32x4*)(ks + k0 + 8 * c); s1 = *(const f32x4*)(ks + k0 + 8 * c + 4); }
#pragma unroll
    for (int j = 0; j < 4; ++j) { const int n = (lane >> 3) + 8 * j; const float* s = scr + (8 * c) * 33 + n;
        u32x4 o; o.x = cvt_pk_bf16(s[0 * 33] * s0[0], s[1 * 33] * s0[1]); o.y = cvt_pk_bf16(s[2 * 33] * s0[2], s[3 * 33] * s0[3]); o.z = cvt_pk_bf16(s[4 * 33] * s1[0], s[5 * 33] * s1[1]); o.w = cvt_pk_bf16(s[6 * 33] * s1[2], s[7 * 33] * s1[3]);
        *(u32x4*)(WT + (size_t)(n0 + n) * ldk + k0 + 8 * c) = o; }
    asm volatile("s_waitcnt lgkmcnt(0)" ::: "memory");
}
__device__ __forceinline__ void rms_row_to_bf16(const float* __restrict__ xrow, const float* __restrict__ g, bf16_t* __restrict__ orow, int lane) {
    const f32x4* xr = (const f32x4*)xrow + lane; const f32x4* gr = (const f32x4*)g + lane;
    f32x4 v[4]; float s = 0.f;
#pragma unroll
    for (int j = 0; j < 4; ++j) { v[j] = xr[64 * j]; s += (v[j][0] * v[j][0] + v[j][1] * v[j][1]) + (v[j][2] * v[j][2] + v[j][3] * v[j][3]); }
    const float rs = 1.0f / sqrtf(wave_sum(s) * (1.0f / 1024.0f) + 1e-6f);
    unsigned long long* o8 = (unsigned long long*)orow + lane;
#pragma unroll
    for (int j = 0; j < 4; ++j) { const f32x4 gg = gr[64 * j]; const f32x4 y = v[j] * rs * gg;
        o8[64 * j] = (unsigned long long)cvt_pk_bf16(y[0], y[1]) | ((unsigned long long)cvt_pk_bf16(y[2], y[3]) << 32); }
}
__device__ __forceinline__ void rms_rows2_to_bf16(const float* __restrict__ xa, const float* __restrict__ xb, const float* __restrict__ g, bf16_t* __restrict__ oa, bf16_t* __restrict__ ob, int lane) {
    const f32x4* ra = (const f32x4*)xa + lane; const f32x4* rb = (const f32x4*)xb + lane; const f32x4* gr = (const f32x4*)g + lane;
    f32x4 va[4], vb[4], gg[4]; float sa = 0.f, sb = 0.f;
#pragma unroll
    for (int j = 0; j < 4; ++j) { va[j] = __builtin_nontemporal_load(ra + 64 * j); vb[j] = __builtin_nontemporal_load(rb + 64 * j); gg[j] = gr[64 * j]; }
#pragma unroll
    for (int j = 0; j < 4; ++j) { sa += (va[j][0] * va[j][0] + va[j][1] * va[j][1]) + (va[j][2] * va[j][2] + va[j][3] * va[j][3]); sb += (vb[j][0] * vb[j][0] + vb[j][1] * vb[j][1]) + (vb[j][2] * vb[j][2] + vb[j][3] * vb[j][3]); }
#pragma unroll
    for (int o = 1; o < 64; o <<= 1) { sa += __shfl_xor(sa, o); sb += __shfl_xor(sb, o); }
    const float rsa = 1.0f / sqrtf(sa * (1.0f / 1024.0f) + 1e-6f), rsb = 1.0f / sqrtf(sb * (1.0f / 1024.0f) + 1e-6f);
    unsigned long long* pa = (unsigned long long*)oa + lane; unsigned long long* pb = (unsigned long long*)ob + lane;
#pragma unroll
    for (int j = 0; j < 4; ++j) { const f32x4 ya = va[j] * rsa * gg[j], yb = vb[j] * rsb * gg[j];
        pa[64 * j] = (unsigned long long)cvt_pk_bf16(ya[0], ya[1]) | ((unsigned long long)cvt_pk_bf16(ya[2], ya[3]) << 32);
        pb[64 * j] = (unsigned long long)cvt_pk_bf16(yb[0], yb[1]) | ((unsigned long long)cvt_pk_bf16(yb[2], yb[3]) << 32); }
}
__device__ __forceinline__ void unpack8(const u32x4 w, float (&f)[8]) { f[0] = bf_lo(w.x); f[1] = bf_hi(w.x); f[2] = bf_lo(w.y); f[3] = bf_hi(w.y); f[4] = bf_lo(w.z); f[5] = bf_hi(w.z); f[6] = bf_lo(w.w); f[7] = bf_hi(w.w); }
__device__ __forceinline__ float bf16_to_f(bf16_t h) { return __uint_as_float(((unsigned)h) << 16); }
__device__ __forceinline__ bf16_t f_to_bf16(float f) { return (bf16_t)(cvt_pk_bf16(f, 0.f) & 0xffffu); }

struct Ctx {
    const float* in[21]; float* out; unsigned char* ws;
    bf16_t *WIN, *WOA, *WOB, *WOUT, *WUP, *WDN, *WG, *WSM, *Z4, *ZG, *XN, *YA, *YB, *MRG, *H1B, *U;
    float *SUMA, *SUMB, *LNST, *SS1, *SS2, *TMP; unsigned* MASK;
};

constexpr int XC_LD = 264;
__device__ __forceinline__ void mixer_a_tile(unsigned char* lds, const Ctx& C, int tile) {
    int tid_ = threadIdx.x; asm volatile("" : "+v"(tid_));
    const int tid = tid_, lane = tid & 63, wave = tid >> 6, fr = lane & 15, fq = lane >> 4;
    const int h = tile & 3, ck = (tile >> 2) & 31, b = tile >> 7;
    const size_t row_base = (size_t)b * SEQ + (size_t)ck * 128;
    bf16_t* XC = (bf16_t*)lds;
    bf16_t* HB = (bf16_t*)(lds + 67584);
    float* H0 = (float*)(lds + 135168);
    const bf16_t* wgr = C.WG + ((size_t)(h * 2 + 0) * 256 + 32 * wave + fr) * 256 + 8 * fq;
    bf16x8 gf[4][4];
#pragma unroll
    for (int k = 0; k < 3; ++k) { gf[k][0] = *(const bf16x8*)(wgr + k * 32); gf[k][1] = *(const bf16x8*)(wgr + 4096 + k * 32); gf[k][2] = *(const bf16x8*)(wgr + 65536 + k * 32); gf[k][3] = *(const bf16x8*)(wgr + 65536 + 4096 + k * 32); }
    {
        const int cc = tid & 31, tg = tid >> 5, ch0 = h * 256 + cc * 8;
        const float* cw = C.in[3]; const float* cbp = C.in[4];
        float w[4][8], cb[8];
#pragma unroll
        for (int k = 0; k < 4; ++k) { const f32x4 w0 = *(const f32x4*)(cw + k * DM + ch0), w1 = *(const f32x4*)(cw + k * DM + ch0 + 4);
#pragma unroll
            for (int j = 0; j < 4; ++j) { w[k][j] = w0[j]; w[k][4 + j] = w1[j]; } }
        { const f32x4 b0 = *(const f32x4*)(cbp + ch0), b1 = *(const f32x4*)(cbp + ch0 + 4);
#pragma unroll
          for (int j = 0; j < 4; ++j) { cb[j] = b0[j]; cb[4 + j] = b1[j]; } }
        u32x4 xr[11];
#pragma unroll
        for (int tt = 0; tt < 11; ++tt) { const int tl = tg * 8 - 3 + tt; const int tglob = ck * 128 + tl;
            xr[tt] = (tglob >= 0) ? __builtin_nontemporal_load((const u32x4*)(C.Z4 + ((size_t)b * SEQ + tglob) * 4096 + ch0)) : (u32x4){0u, 0u, 0u, 0u}; }
#pragma unroll
        for (int t = 0; t < 8; ++t) { float o[8];
#pragma unroll
            for (int j = 0; j < 8; ++j) o[j] = cb[j];
#pragma unroll
            for (int k = 0; k < 4; ++k) { float x[8]; unpack8(xr[t + 3 - k], x);
#pragma unroll
                for (int j = 0; j < 8; ++j) o[j] += w[k][j] * x[j]; }
            u32x4 pk; pk.x = cvt_pk_bf16(o[0], o[1]); pk.y = cvt_pk_bf16(o[2], o[3]); pk.z = cvt_pk_bf16(o[4], o[5]); pk.w = cvt_pk_bf16(o[6], o[7]);
            *(u32x4*)(XC + (tg * 8 + t) * XC_LD + cc * 8) = pk; }
    }
    __syncthreads();
    f32x4 accr[2][8], acci[2][8];
#pragma unroll
    for (int n = 0; n < 2; ++n)
#pragma unroll
        for (int m = 0; m < 8; ++m) { accr[n][m] = (f32x4){0.f, 0.f, 0.f, 0.f}; acci[n][m] = (f32x4){0.f, 0.f, 0.f, 0.f}; }
    {
        const bf16_t* xa = XC + fr * XC_LD + 8 * fq;
#pragma unroll
        for (int ks = 0; ks < 8; ++ks) {
            if (ks + 3 < 8) { const bf16_t* wn = wgr + (ks + 3) * 32; bf16x8* d = gf[(ks + 3) % 4];
                d[0] = *(const bf16x8*)(wn); d[1] = *(const bf16x8*)(wn + 4096); d[2] = *(const bf16x8*)(wn + 65536); d[3] = *(const bf16x8*)(wn + 65536 + 4096); }
            const bf16x8* cf = gf[ks % 4];
#pragma unroll
            for (int m = 0; m < 8; ++m) { const bf16x8 a = *(const bf16x8*)(xa + m * 16 * XC_LD + ks * 32);
                accr[0][m] = __builtin_amdgcn_mfma_f32_16x16x32_bf16(a, cf[0], accr[0][m], 0, 0, 0);
                accr[1][m] = __builtin_amdgcn_mfma_f32_16x16x32_bf16(a, cf[1], accr[1][m], 0, 0, 0);
                acci[0][m] = __builtin_amdgcn_mfma_f32_16x16x32_bf16(a, cf[2], acci[0][m], 0, 0, 0);
                acci[1][m] = __builtin_amdgcn_mfma_f32_16x16x32_bf16(a, cf[3], acci[1][m], 0, 0, 0); }
            asm volatile("" ::: "memory");
        }
    }
#pragma unroll
    for (int n = 0; n < 2; ++n) {
        const int chl = 32 * wave + 16 * n + fr, ch = h * 256 + chl;
        const float brv = C.in[6][ch], biv = C.in[8][ch], lam = C.in[9][ch];
        const float sp8 = -8.0f * (fmaxf(-lam, 0.f) + log1pf(__expf(-fabsf(lam))));
        const float sp8l2 = sp8 * 1.4426950409f, sp16 = 2.0f * sp8; const float nbr = -1.4426950409f * brv, nbi = -1.4426950409f * biv;
        float hc = 0.f, Ac = 1.f;
#pragma unroll
        for (int m = 0; m < 8; ++m) {
            float a[4], bx[4];
#pragma unroll
            for (int hh = 0; hh < 2; ++hh) {
                const int t = 16 * m + 4 * fq + 2 * hh;
                const f32x2 xcv = {bf16_to_f(XC[t * XC_LD + chl]), bf16_to_f(XC[(t + 1) * XC_LD + chl])};
                const f32x2 pr = {accr[n][m][2 * hh], accr[n][m][2 * hh + 1]}, pi = {acci[n][m][2 * hh], acci[n][m][2 * hh + 1]};
                f32x2 xr = pr * (-1.4426950409f) + nbr, xi = pi * (-1.4426950409f) + nbi;
                xr.x = fminf(xr.x, 60.f); xr.y = fminf(xr.y, 60.f); xi.x = fminf(xi.x, 60.f); xi.y = fminf(xi.y, 60.f);
                f32x2 er, ei; er.x = __builtin_amdgcn_exp2f(xr.x); er.y = __builtin_amdgcn_exp2f(xr.y); ei.x = __builtin_amdgcn_exp2f(xi.x); ei.y = __builtin_amdgcn_exp2f(xi.y);
                const f32x2 dr = er + 1.0f, di = ei + 1.0f, dd = dr * di;
                f32x2 inv; inv.x = __builtin_amdgcn_rcpf(dd.x); inv.y = __builtin_amdgcn_rcpf(dd.y);
                const f32x2 r = di * inv, ig = dr * inv;
                const f32x2 l2 = r * sp8l2;
                f32x2 av; av.x = __builtin_amdgcn_exp2f(l2.x); av.y = __builtin_amdgcn_exp2f(l2.y);
                const f32x2 x2 = r * sp16;
                f32x2 q = x2 * 0.0013888889f + 0.0083333338f; q = q * x2 + 0.041666668f; q = q * x2 + 0.16666667f; q = q * x2 + 0.5f; q = q * x2 + 1.0f;
                const f32x2 ser = -x2 * q, dir = 1.0f - av * av;
                f32x2 m2; m2.x = fmaxf((x2.x > -0.25f) ? ser.x : dir.x, 0.f); m2.y = fmaxf((x2.y > -0.25f) ? ser.y : dir.y, 0.f);
                f32x2 mu; mu.x = __builtin_amdgcn_sqrtf(m2.x); mu.y = __builtin_amdgcn_sqrtf(m2.y);
                const f32x2 bxx = xcv * ig * mu;
                a[2 * hh] = av.x; a[2 * hh + 1] = av.y; bx[2 * hh] = bxx.x; bx[2 * hh + 1] = bxx.y;
            }
            const float p0 = a[0], h0l = bx[0];
            const float p1 = p0 * a[1], h1l = h0l * a[1] + bx[1];
            const float p2 = p1 * a[2], h2l = h1l * a[2] + bx[2];
            const float p3 = p2 * a[3], h3l = h2l * a[3] + bx[3];
            float Ai = p3, Bi = h3l;
            float At = __shfl_up(Ai, 16), Bt = __shfl_up(Bi, 16);
            if (fq >= 1) { Bi = Bt * Ai + Bi; Ai = At * Ai; }
            At = __shfl_up(Ai, 32); Bt = __shfl_up(Bi, 32);
            if (fq >= 2) { Bi = Bt * Ai + Bi; Ai = At * Ai; }
            const float Am = __shfl(Ai, 48 + fr), Bm = __shfl(Bi, 48 + fr);
            float Ae = __shfl_up(Ai, 16), Be = __shfl_up(Bi, 16);
            if (fq == 0) { Ae = 1.f; Be = 0.f; }
            const float hin = Be + Ae * hc, Pin = Ae * Ac;
            accr[n][m] = (f32x4){Pin * p0, Pin * p1, Pin * p2, Pin * p3};
            acci[n][m] = (f32x4){h0l + p0 * hin, h1l + p1 * hin, h2l + p2 * hin, h3l + p3 * hin};
            hc = hc * Am + Bm; Ac *= Am;
        }
        if (fq == 0) { const size_t o = ((size_t)(b * NCHUNK + ck)) * DM + ch;
            __hip_atomic_store(C.SUMA + o, Ac, __ATOMIC_RELAXED, __HIP_MEMORY_SCOPE_AGENT); __hip_atomic_store(C.SUMB + o, hc, __ATOMIC_RELAXED, __HIP_MEMORY_SCOPE_AGENT); }
    }
    asm volatile("s_waitcnt vmcnt(0)" ::: "memory");
    __syncthreads();
    if (tid == 0) {
        unsigned* mk = C.MASK + 64 * (b * 4 + h);
        __hip_atomic_fetch_or(mk, 1u << ck, __ATOMIC_RELAXED, __HIP_MEMORY_SCOPE_AGENT);
        const unsigned need = (1u << ck) - 1u; unsigned sp = 0u;
        while ((__hip_atomic_load(mk, __ATOMIC_RELAXED, __HIP_MEMORY_SCOPE_AGENT) & need) != need) { __builtin_amdgcn_s_sleep(1); if (++sp > (1u << 22)) break; }
        __builtin_amdgcn_fence(__ATOMIC_ACQUIRE, "agent");
        asm volatile("s_waitcnt vmcnt(0)" ::: "memory");
    }
    __syncthreads();
    if (tid < 256) {
        const int ch = h * 256 + tid; float hcar = 0.f;
        for (int c2 = 0; c2 < ck; c2 += 8) { float a[8], bb[8];
#pragma unroll
            for (int j = 0; j < 8; ++j) { const bool ok = (c2 + j) < ck; const size_t o = ((size_t)(b * NCHUNK + (ok ? c2 + j : 0))) * DM + ch;
                a[j] = ok ? __hip_atomic_load(C.SUMA + o, __ATOMIC_RELAXED, __HIP_MEMORY_SCOPE_AGENT) : 1.f; bb[j] = ok ? __hip_atomic_load(C.SUMB + o, __ATOMIC_RELAXED, __HIP_MEMORY_SCOPE_AGENT) : 0.f; }
#pragma unroll
            for (int j = 0; j < 8; ++j) hcar = hcar * a[j] + bb[j]; }
        H0[tid] = hcar;
    }
    __syncthreads();
#pragma unroll
    for (int n = 0; n < 2; ++n) { const int chl = 32 * wave + 16 * n + fr; const float h0 = H0[chl];
#pragma unroll
        for (int m = 0; m < 8; ++m)
#pragma unroll
            for (int i = 0; i < 4; ++i) HB[(16 * m + 4 * fq + i) * XC_LD + chl] = f_to_bf16(acci[n][m][i] + accr[n][m][i] * h0); }
    __syncthreads();
    {
        const int cc = tid & 31, tg = tid >> 5;
#pragma unroll
        for (int t4 = 0; t4 < 8; t4 += 4) {
        u32x4 gav[4];
#pragma unroll
        for (int tt = 0; tt < 4; ++tt) gav[tt] = __builtin_nontemporal_load((const u32x4*)(C.Z4 + (row_base + tg * 8 + t4 + tt) * 4096 + 1024 + h * 256 + cc * 8));
#pragma unroll
        for (int tt = 0; tt < 4; ++tt) { const int t = tg * 8 + t4 + tt;
            float hv[8], gv[8]; unpack8(*(const u32x4*)(HB + t * XC_LD + cc * 8), hv); unpack8(gav[tt], gv);
            u32x4 pk; pk.x = cvt_pk_bf16(hv[0] * gv[0], hv[1] * gv[1]); pk.y = cvt_pk_bf16(hv[2] * gv[2], hv[3] * gv[3]); pk.z = cvt_pk_bf16(hv[4] * gv[4], hv[5] * gv[5]); pk.w = cvt_pk_bf16(hv[6] * gv[6], hv[7] * gv[7]);
            *(u32x4*)(C.YA + (row_base + t) * 2048 + h * 256 + cc * 8) = pk; }
        asm volatile("" ::: "memory"); }
    }
    __syncthreads();
}

constexpr int WS_LD = 136;
__device__ __forceinline__ void mixer_b_tile(unsigned char* lds, const Ctx& C, int tile) {
    int tid_ = threadIdx.x; asm volatile("" : "+v"(tid_));
    const int tid = tid_, lane = tid & 63, wave = tid >> 6, fr = lane & 15, fq = lane >> 4;
    const int g = tile & 3, ck = (tile >> 2) & 31, b = tile >> 7;
    const size_t row_base = (size_t)b * SEQ + (size_t)ck * 128;
    bf16_t* WSL = (bf16_t*)lds;
    bf16_t* VT = (bf16_t*)(lds + 34816);
    bf16_t* SB = VT;
#pragma unroll
    for (int j = 0; j < 4; ++j) { const int q = tid + 512 * j, t = q >> 4, s8 = q & 15;
        *(u32x4*)(WSL + t * WS_LD + s8 * 8) = *(const u32x4*)(C.WSM + (size_t)g * 16384 + t * 128 + s8 * 8); }
    {
        const int wv = __builtin_amdgcn_readfirstlane(wave);
        u32x4 vv[4][2];
#pragma unroll
        for (int q = 0; q < 4; ++q) { const int ch = g * 256 + (4 * wv + q) * 8;
            vv[q][0] = __builtin_nontemporal_load((const u32x4*)(C.Z4 + (row_base + 2 * lane) * 4096 + 3072 + ch)); vv[q][1] = __builtin_nontemporal_load((const u32x4*)(C.Z4 + (row_base + 2 * lane + 1) * 4096 + 3072 + ch)); }
        f32x4 st = *(const f32x4*)(C.LNST + (row_base + 2 * lane) * 2);
        { const float m0 = st[0] * (1.0f / 1024.0f), m1 = st[2] * (1.0f / 1024.0f);
          st[1] = __builtin_amdgcn_rsqf(fmaxf(st[1] * (1.0f / 1024.0f) - m0 * m0, 0.f) + 1e-5f); st[3] = __builtin_amdgcn_rsqf(fmaxf(st[3] * (1.0f / 1024.0f) - m1 * m1, 0.f) + 1e-5f); st[0] = m0; st[2] = m1; }
#pragma unroll
        for (int q = 0; q < 4; ++q) { const int chl = (4 * wv + q) * 8, ch = g * 256 + chl;
            float v0[8], v1[8]; unpack8(vv[q][0], v0); unpack8(vv[q][1], v1);
            float lg[8], lb[8];
            { const f32x4 a0 = *(const f32x4*)(C.in[11] + ch), a1 = *(const f32x4*)(C.in[11] + ch + 4), b0 = *(const f32x4*)(C.in[12] + ch), b1 = *(const f32x4*)(C.in[12] + ch + 4);
#pragma unroll
              for (int j = 0; j < 4; ++j) { lg[j] = a0[j]; lg[4 + j] = a1[j]; lb[j] = b0[j]; lb[4 + j] = b1[j]; } }
#pragma unroll
            for (int j = 0; j < 8; ++j) { const float y0 = (v0[j] - st[0]) * st[1] * lg[j] + lb[j], y1 = (v1[j] - st[2]) * st[3] * lg[j] + lb[j];
                *(unsigned*)(VT + (chl + j) * WS_LD + 2 * lane) = cvt_pk_bf16(y0, y1); }
        }
    }
    __syncthreads();
    f32x4 acc[2][8];
#pragma unroll
    for (int n = 0; n < 2; ++n)
#pragma unroll
        for (int m = 0; m < 8; ++m) acc[n][m] = (f32x4){0.f, 0.f, 0.f, 0.f};
#pragma unroll
    for (int ks = 0; ks < 4; ++ks) {
        const bf16x8 b0 = *(const bf16x8*)(VT + (32 * wave + fr) * WS_LD + 32 * ks + 8 * fq), b1 = *(const bf16x8*)(VT + (32 * wave + 16 + fr) * WS_LD + 32 * ks + 8 * fq);
#pragma unroll
        for (int m = 0; m < 8; ++m) if (m >= 2 * ks) { const bf16x8 a = *(const bf16x8*)(WSL + (16 * m + fr) * WS_LD + 32 * ks + 8 * fq);
            acc[0][m] = __builtin_amdgcn_mfma_f32_16x16x32_bf16(a, b0, acc[0][m], 0, 0, 0);
            acc[1][m] = __builtin_amdgcn_mfma_f32_16x16x32_bf16(a, b1, acc[1][m], 0, 0, 0); }
    }
    __syncthreads();
    {
        const float* bs = C.in[14] + g * 128;
#pragma unroll
        for (int m = 0; m < 8; ++m) { const f32x4 bv = *(const f32x4*)(bs + 16 * m + 4 * fq);
#pragma unroll
            for (int n = 0; n < 2; ++n)
#pragma unroll
                for (int i = 0; i < 4; ++i) SB[(16 * m + 4 * fq + i) * XC_LD + 32 * wave + 16 * n + fr] = f_to_bf16(acc[n][m][i] + bv[i]); }
    }
    __syncthreads();
    {
        const int cc = tid & 31, tg = tid >> 5;
#pragma unroll
        for (int t4 = 0; t4 < 8; t4 += 4) {
        u32x4 uvv[4];
#pragma unroll
        for (int tt = 0; tt < 4; ++tt) uvv[tt] = __builtin_nontemporal_load((const u32x4*)(C.Z4 + (row_base + tg * 8 + t4 + tt) * 4096 + 2048 + g * 256 + cc * 8));
#pragma unroll
        for (int tt = 0; tt < 4; ++tt) { const int t = tg * 8 + t4 + tt;
            float sv[8], uv[8]; unpack8(*(const u32x4*)(SB + t * XC_LD + cc * 8), sv); unpack8(uvv[tt], uv);
            u32x4 pk; pk.x = cvt_pk_bf16(sv[0] * uv[0], sv[1] * uv[1]); pk.y = cvt_pk_bf16(sv[2] * uv[2], sv[3] * uv[3]); pk.z = cvt_pk_bf16(sv[4] * uv[4], sv[5] * uv[5]); pk.w = cvt_pk_bf16(sv[6] * uv[6], sv[7] * uv[7]);
            *(u32x4*)(C.YA + (row_base + t) * 2048 + 1024 + g * 256 + cc * 8) = pk; }
        asm volatile("" ::: "memory"); }
    }
    __syncthreads();
}

#define LAS __attribute__((address_space(3)))
#define XB_TMO      128
#define XB_XCNT(j)  (256  + 64 * (j))
#define XB_XSUB(j)  (1280 + 64 * (j))
#define XB_XGEN(j)  (2304 + 64 * (j))
#define XB_TOP      3328
#define XB_TOPGEN   3392
#define XCD_BAR_WORDS 3456
#define XB_SPIN_CAP (1u << 18)

__device__ __forceinline__ unsigned xb_ld(unsigned* p)              { return __hip_atomic_load(p, __ATOMIC_RELAXED, __HIP_MEMORY_SCOPE_AGENT); }
__device__ __forceinline__ unsigned xb_add(unsigned* p, unsigned v) { return __hip_atomic_fetch_add(p, v, __ATOMIC_RELAXED, __HIP_MEMORY_SCOPE_AGENT); }
__device__ __forceinline__ unsigned xb_xcc_id() { return (unsigned)__builtin_amdgcn_s_getreg((3 << 11) | 20) & 0xFu; }
#define XB_SPIN(cond, bar) do { unsigned _sp = 0; while (cond) { __builtin_amdgcn_s_sleep(1); \
    if ((++_sp & 255u) == 0u) { if (xb_ld(&(bar)[XB_TMO])) break; if (_sp > XB_SPIN_CAP) { atomicAdd(&(bar)[XB_TMO], 1u); break; } } } } while (0)

struct XcdBarrier {
    unsigned* bar; unsigned x;
    volatile LAS unsigned* st;
};

__device__ __forceinline__ XcdBarrier xcd_barrier_post(unsigned* bar, volatile LAS unsigned* st) {
    XcdBarrier b; b.bar = bar; b.x = xb_xcc_id(); b.st = st;
    if (threadIdx.x == 0) (void)xb_add(&bar[XB_XCNT(b.x)], 1u);
    return b;
}
__device__ __forceinline__ void xcd_barrier_complete(unsigned* bar, unsigned x, unsigned& nloc, unsigned& nx) {
    const unsigned G = gridDim.x * gridDim.y * gridDim.z;
    unsigned sum, cnt, mine, sp = 0u;
    for (;;) {
        sum = 0u; cnt = 0u; mine = 0u;
#pragma unroll
        for (unsigned j = 0; j < 16; ++j) { const unsigned c = xb_ld(&bar[XB_XCNT(j)]); sum += c; cnt += (c > 0u) ? 1u : 0u; mine = (j == x) ? c : mine; }
        if (sum == G) break;
        __builtin_amdgcn_s_sleep(1);
        if ((++sp & 255u) == 0u) { if (xb_ld(&bar[XB_TMO])) break; if (sp > XB_SPIN_CAP) { atomicAdd(&bar[XB_TMO], 1u); break; } }
    }
    nloc = mine > 0u ? mine : 1u; nx = cnt > 0u ? cnt : 1u;
}

__device__ __forceinline__ void xcd_barrier(const XcdBarrier& b) {
    asm volatile("s_waitcnt vmcnt(0)" ::: "memory");
    __syncthreads();
    if (threadIdx.x == 0) {
        unsigned* bar = b.bar;
        __builtin_amdgcn_s_waitcnt(0);
        unsigned nloc = b.st[0], nx = b.st[1];
        if (nloc == 0u) { xcd_barrier_complete(bar, b.x, nloc, nx); b.st[0] = nloc; b.st[1] = nx; }
        const unsigned old = xb_add(&bar[XB_XSUB(b.x)], 1u);
        const unsigned gen = old / nloc;
        if (old + 1u == (gen + 1u) * nloc) {
            __builtin_amdgcn_fence(__ATOMIC_RELEASE, "agent");
            asm volatile("s_waitcnt vmcnt(0)" ::: "memory");
            const unsigned og = xb_add(&bar[XB_TOP], 1u);
            const unsigned tg = og / nx;
            if (og + 1u == (tg + 1u) * nx) xb_add(&bar[XB_TOPGEN], 1u);
            else XB_SPIN(xb_ld(&bar[XB_TOPGEN]) == tg, bar);
            __builtin_amdgcn_fence(__ATOMIC_ACQUIRE, "agent");
            xb_add(&bar[XB_XGEN(b.x)], 1u);
            asm volatile("s_waitcnt vmcnt(0)" ::: "memory");
        } else {
            XB_SPIN(xb_ld(&bar[XB_XGEN(b.x)]) == gen, bar);
            __builtin_amdgcn_fence(__ATOMIC_ACQUIRE, "agent");
            asm volatile("s_waitcnt vmcnt(0)" ::: "memory");
        }
    }
    __syncthreads();
}
__global__ void __launch_bounds__(512, 2) hybrid_fwd(Params P) {
    extern __shared__ __attribute__((aligned(16))) unsigned char lds[];
    cg::grid_group grid = cg::this_grid();
    const int G = gridDim.x, NGW = G * 8;
    Ctx C;
#pragma unroll
    for (int i = 0; i < 21; ++i) C.in[i] = P.in[i];
    C.out = P.out; C.ws = P.ws;
    unsigned char* ws = P.ws;
    C.WIN = (bf16_t*)(ws + WS_WIN); C.WOA = (bf16_t*)(ws + WS_WOA); C.WOB = (bf16_t*)(ws + WS_WOB); C.WOUT = (bf16_t*)(ws + WS_WOUT); C.WUP = (bf16_t*)(ws + WS_WUP); C.WDN = (bf16_t*)(ws + WS_WDN);
    C.WG = (bf16_t*)(ws + WS_WG); C.WSM = (bf16_t*)(ws + WS_WSM); C.Z4 = (bf16_t*)(ws + WS_Z4); C.ZG = (bf16_t*)P.out; C.XN = (bf16_t*)(ws + WS_XN + 1 * MiB + 8192); C.YA = (bf16_t*)(ws + WS_YA); C.YB = (bf16_t*)(ws + WS_YB);
    C.MRG = (bf16_t*)(ws + WS_MRG); C.H1B = (bf16_t*)(ws + WS_H1B); C.U = (bf16_t*)(ws + WS_U);
    C.SUMA = (float*)(ws + WS_SUMA); C.SUMB = (float*)(ws + WS_SUMB); C.LNST = (float*)(ws + WS_LNST); C.SS1 = (float*)(ws + WS_SS1); C.SS2 = (float*)(ws + WS_SS2); C.TMP = (float*)(ws + WS_TMP); C.MASK = (unsigned*)(ws + WS_BAR) + 4096;
    PG8_LAS unsigned char* ldsl = (PG8_LAS unsigned char*)lds;
    volatile LAS unsigned* bst = (volatile LAS unsigned*)(ldsl + LDS_BYTES - 16);
    if (threadIdx.x < 4) bst[threadIdx.x] = 0u;
    __syncthreads();
    const XcdBarrier bar = xcd_barrier_post((unsigned*)(ws + WS_BAR), bst);
    if (G > 65535) grid.sync();
#define GRID_BAR() xcd_barrier(bar)

    {
        int t0_ = threadIdx.x; asm volatile("" : "+v"(t0_)); const int tid = t0_, lane = tid & 63, wave = tid >> 6, gw = blockIdx.x * 8 + wave;
        float* scr = (float*)(lds + wave * 8448);
        constexpr int I_IN = 16 * 192, I_SQ = 16 * 32, I_UP = 16 * 128, I_DN = 64 * 32, I_G = 4 * 8;
        constexpr int NITEMS = I_IN + 3 * I_SQ + I_UP + I_DN + 8 * I_G;
        for (int it = gw; it < NITEMS; it += NGW) {
            int r = it;
            if (r < I_IN) { tr_item(C.in[2], DIN, DM, C.WIN, nullptr, scr, r, lane); continue; } r -= I_IN;
            if (r < I_SQ) { tr_item(C.in[10], DM, DM, C.WOA, nullptr, scr, r, lane, 2048); continue; } r -= I_SQ;
            if (r < I_SQ) { tr_item(C.in[15], DM, DM, C.WOA + 1024, nullptr, scr, r, lane, 2048); continue; } r -= I_SQ;
            if (r < I_SQ) { tr_item(C.in[16], DM, DM, C.WOUT, nullptr, scr, r, lane); continue; } r -= I_SQ;
            if (r < I_UP) { tr_item(C.in[18], DFF, DM, C.WUP, C.in[17], scr, r, lane); continue; } r -= I_UP;
            if (r < I_DN) { tr_item(C.in[19], DM, DFF, C.WDN, nullptr, scr, r, lane); continue; } r -= I_DN;
            { const int mat = r / I_G, item = r % I_G, hh = mat >> 1, gate = mat & 1;
              tr_item(C.in[gate ? 7 : 5] + (size_t)hh * 65536, 256, 256, C.WG + (size_t)(hh * 2 + gate) * 65536, nullptr, scr, item, lane); }
        }
        for (int i = blockIdx.x * 512 + tid; i < 4 * 128 * 128; i += G * 512) { const int t = (i >> 7) & 127, s = i & 127; C.WSM[i] = (s <= t) ? pg8::cvt_pk_bf16(C.in[13][i], 0.f) & 0xffffu : 0; }
        for (int i = blockIdx.x * 512 + tid; i < MTOK; i += G * 512) { C.SS1[i] = 0.f; C.SS2[i] = 0.f; C.LNST[2 * i] = 0.f; C.LNST[2 * i + 1] = 0.f; }
        for (int m = gw; m < MTOK; m += 2 * NGW) {
            const int m2 = m + NGW;
            if (m2 < MTOK) rms_rows2_to_bf16(C.in[0] + (size_t)m * DM, C.in[0] + (size_t)m2 * DM, C.in[1], C.XN + (size_t)m * DM, C.XN + (size_t)m2 * DM, lane);
            else rms_row_to_bf16(C.in[0] + (size_t)m * DM, C.in[1], C.XN + (size_t)m * DM, lane);
        }
    }
    GRID_BAR();
    { pg8::Gemm g{C.XN, C.WIN, MTOK, DIN, DM}; pg8::StaticOrder S; S.init(MTOK, DIN, G, (int)blockIdx.x, (blockIdx.x & 1) ? 3 : 0);
      pg8::EpiZ E{C.Z4, C.ZG, C.LNST};
      pg8::gemm_phase<pg8::EpiZ, pg8::StaticOrder, true, true>(ldsl, g, S, E); }
    GRID_BAR();
    if (blockIdx.x & 2) for (int t = blockIdx.x; t < 512; t += G) mixer_b_tile(lds, C, t);
    for (int t = blockIdx.x; t < 512; t += G) mixer_a_tile(lds, C, t);
    if (!(blockIdx.x & 2)) for (int t = blockIdx.x; t < 512; t += G) mixer_b_tile(lds, C, t);
    GRID_BAR();
    { pg8::Gemm g{C.YA, C.WOA, MTOK, DM, 2 * DM}; pg8::StaticOrder S; S.init(MTOK, DM, G, (int)blockIdx.x);
      pg8::EpiMerge2 E{(const unsigned char*)C.ZG, C.MRG};
      pg8::gemm_phase<pg8::EpiMerge2, pg8::StaticOrder, true, true>(ldsl, g, S, E); }
    GRID_BAR();
    { pg8::Gemm g{C.MRG, C.WOUT, MTOK, DM, DM}; pg8::StaticOrder S; S.init(MTOK, DM, G, (int)blockIdx.x);
      pg8::EpiH1 E{C.in[0], C.out, C.H1B, C.SS1, G == 256 ? 0 : 1};
      pg8::gemm_phase<pg8::EpiH1, pg8::StaticOrder, true, true>(ldsl, g, S, E); }
    GRID_BAR();
    { pg8::Gemm g{C.H1B, C.WUP, MTOK, DFF, DM}; pg8::StaticOrder S; S.init(MTOK, DFF, G, (int)blockIdx.x);
      pg8::EpiUp E{C.SS1, C.U};
      pg8::gemm_phase<pg8::EpiUp, pg8::StaticOrder, true, true>(ldsl, g, S, E); }
    GRID_BAR();
    if (G == 256) {
      pg8::Gemm g{C.U, C.WDN, MTOK, DM, DFF}; pg8::StaticOrder S; S.init(MTOK, DM, G, (int)blockIdx.x);
      pg8::EpiDownNorm E{C.H1B, C.out, C.SS2, C.MASK + 1024, C.in[20]};
      pg8::gemm_phase<pg8::EpiDownNorm, pg8::StaticOrder, false, true>(ldsl, g, S, E);
    } else {
      { pg8::Gemm g{C.U, C.WDN, MTOK, DM, DFF}; pg8::StaticOrder S; S.init(MTOK, DM, G, (int)blockIdx.x);
        pg8::EpiDown E{C.out, C.SS2};
        pg8::gemm_phase<pg8::EpiDown, pg8::StaticOrder, true, true>(ldsl, g, S, E); }
      GRID_BAR();
      int t8_ = threadIdx.x; asm volatile("" : "+v"(t8_)); const int lane = t8_ & 63, gw = blockIdx.x * 8 + (t8_ >> 6);
      for (int m = gw; m < MTOK; m += NGW) {
        f32x4* xr = (f32x4*)(C.out + (size_t)m * DM) + lane; const f32x4* gr = (const f32x4*)C.in[20] + lane;
        const float rs = 1.0f / sqrtf(C.SS2[m] * (1.0f / 1024.0f) + 1e-6f);
#pragma unroll
        for (int j = 0; j < 4; ++j) xr[64 * j] = xr[64 * j] * rs * gr[64 * j];
      }
    }
}

extern "C" void kernel_launch(void* const* d_in, const int* in_sizes, int n_in, void* d_out, int out_size, void* d_ws, size_t ws_size, hipStream_t stream) {
    static int grid_blocks = 0;
    if (grid_blocks == 0) {
        if (n_in != 21 || out_size != MTOK * DM || ws_size < WS_END) { fprintf(stderr, "kernel_launch: unexpected shapes (n_in %d, out %d, ws %zu)\n", n_in, out_size, ws_size); grid_blocks = -1; return; }
        int dev = 0, cus = 0, per_cu = 0;
        hipGetDevice(&dev); hipDeviceGetAttribute(&cus, hipDeviceAttributeMultiprocessorCount, dev);
        if (hipFuncSetAttribute((const void*)hybrid_fwd, hipFuncAttributeMaxDynamicSharedMemorySize, LDS_BYTES) != hipSuccess) fprintf(stderr, "kernel_launch: hipFuncSetAttribute failed\n");
        if (hipOccupancyMaxActiveBlocksPerMultiprocessor(&per_cu, (const void*)hybrid_fwd, 512, LDS_BYTES) != hipSuccess || per_cu < 1) { fprintf(stderr, "kernel_launch: occupancy query says %d\n", per_cu); per_cu = 1; }
        (void)hipGetLastError();
        grid_blocks = cus * 1;
    }
    if (grid_blocks < 0) return;
    Params p{};
    for (int i = 0; i < 21; ++i) p.in[i] = (const float*)d_in[i];
    p.out = (float*)d_out; p.ws = (unsigned char*)d_ws;
    if (hipMemsetAsync((char*)d_ws + WS_BAR, 0, (4096 + 1024 + 64 * 64) * sizeof(unsigned), stream) != hipSuccess) { fprintf(stderr, "kernel_launch: memset failed\n"); return; }
    void* args[] = {&p};
    hipError_t e = hipLaunchCooperativeKernel((const void*)hybrid_fwd, dim3(grid_blocks), dim3(512), args, LDS_BYTES, stream);
    if (e != hipSuccess) fprintf(stderr, "cooperative launch failed: %s (grid %d)\n", hipGetErrorString(e), grid_blocks);
}
```

```cpp
#include <hip/hip_runtime.h>
#include <hip/hip_cooperative_groups.h>
#include <cstdio>
#include <cstdint>
namespace cg = cooperative_groups;
namespace pg8 {
#define PG8_LAS __attribute__((address_space(3)))
typedef unsigned short bf16_t;
typedef short bf16x8 __attribute__((ext_vector_type(8)));
typedef float f32x4 __attribute__((ext_vector_type(4)));
typedef unsigned u32x4 __attribute__((ext_vector_type(4)));
constexpr int BM = 256, BK = 64, HALF = 128, HTB = HALF * BK * 2  , STAGE_BYTES = 8 * HTB, NXCD = 8, WGM = 8;

__host__ __device__ __forceinline__ int lds_byte(int r, int c) { const int st = (r >> 4) * 2 + (c >> 5), rr = r & 15, cc = c & 31, ob = rr * 64 + cc * 2; return st * 1024 + (ob ^ (((ob >> 9) & 1) << 5)); }
__host__ __device__ __forceinline__ void stage_rc(int b, int& R, int& C) { const int st = b / 1024, sb = b % 1024, swz = sb ^ (((sb >> 9) & 1) << 5); R = (st >> 1) * 16 + swz / 64; C = (st & 1) * 32 + (swz % 64) / 2; }
__host__ __device__ __forceinline__ int perm32(int rho) { const int n = rho >> 4, i = rho & 15; return 8 * (i >> 2) + 4 * n + (i & 3); }

struct Unit { int pm, pn; };
struct Gemm { const bf16_t* A; const bf16_t* Bt; int M, N, K; };

struct StaticOrder {
    int nM, nN, nwg, G, c, rot, nround;
    __host__ __device__ void init(int M, int N, int G_, int c_, int rot_ = 0) { nM = M / BM; nN = N / BM; nwg = nM * nN; G = G_; c = c_; nround = nwg / G; rot = (nwg % G == 0 && nround > 1) ? rot_ % nround : 0; }
    __host__ __device__ bool next(int i, Unit& u) const {
        if ((long)i * G + c >= nwg) return false;
        int ii = i + rot; if (rot && ii >= nround) ii -= nround;
        const long L = (long)ii * G + c;
        int wgid = (int)L; { const int q = nwg / NXCD, r = nwg % NXCD, xcd = wgid % NXCD, off = wgid / NXCD; wgid = (xcd < r ? xcd * (q + 1) : r * (q + 1) + (xcd - r) * q) + off; }
        const int nig = WGM * nN, gid = wgid / nig, fm = gid * WGM, gsz = (nM - fm) < WGM ? (nM - fm) : WGM;
        u.pm = fm + ((wgid % nig) % gsz); u.pn = (wgid % nig) / gsz; return true;
    }
    __device__ __forceinline__ void a_ready(const Unit&) const {}
    __device__ __forceinline__ void done(const Unit&) const {}
};

__device__ __forceinline__ unsigned cvt_pk_bf16(float lo, float hi) { unsigned r; asm volatile("v_cvt_pk_bf16_f32 %0, %1, %2" : "=v"(r) : "v"(lo), "v"(hi)); return r; }
__device__ __forceinline__ float sigmoid_f(float x) { return __builtin_amdgcn_rcpf(1.0f + __builtin_amdgcn_exp2f(-1.4426950409f * x)); }
__device__ __forceinline__ float gelu_tanh_f(float x) { const float t = x * (1.5957691216f + 0.0713548163f * x * x); return x * __builtin_amdgcn_rcpf(1.0f + __builtin_amdgcn_exp2f(-1.4426950409f * t)); }
typedef float f32x2e __attribute__((ext_vector_type(2)));
__device__ __forceinline__ f32x2e gelu_tanh_pk(f32x2e x) { const f32x2e x2 = x * x; const f32x2e t = x * (x2 * (-0.1029432407f) + (-2.3022081925f));
    f32x2e e; e.x = __builtin_amdgcn_exp2f(t.x); e.y = __builtin_amdgcn_exp2f(t.y); const f32x2e d = e + 1.0f; f32x2e r; r.x = __builtin_amdgcn_rcpf(d.x); r.y = __builtin_amdgcn_rcpf(d.y); return x * r; }
__device__ __forceinline__ f32x2e sigmoid_pk(f32x2e x) { const f32x2e t = x * (-1.4426950409f); f32x2e e; e.x = __builtin_amdgcn_exp2f(t.x); e.y = __builtin_amdgcn_exp2f(t.y); const f32x2e d = e + 1.0f;
    f32x2e r; r.x = __builtin_amdgcn_rcpf(d.x); r.y = __builtin_amdgcn_rcpf(d.y); return r; }
__device__ __forceinline__ float bf_lo(unsigned w) { return __uint_as_float(w << 16); }
__device__ __forceinline__ float bf_hi(unsigned w) { return __uint_as_float(w & 0xffff0000u); }
__device__ __forceinline__ u32x4 pack8(const f32x4 v0, const f32x4 v1) { u32x4 w; w.x = cvt_pk_bf16(v0[0], v0[1]); w.y = cvt_pk_bf16(v0[2], v0[3]); w.z = cvt_pk_bf16(v1[0], v1[1]); w.w = cvt_pk_bf16(v1[2], v1[3]); return w; }

struct EpiZ {
    static constexpr bool PERM = true, AFTER_DRAIN = false, MIDK = false;
    bf16_t* Z4; bf16_t* ZG; float* LNS;
    template <int MODE> __device__ __forceinline__ void body(const f32x4 (&acc)[2][2][4][2], int pn, int row0, int wc, int fq) const {
        typedef unsigned u32x2v __attribute__((ext_vector_type(2)));
        const int col0 = (MODE == 3 ? (pn - 16) * BM : pn * BM) + wc * 32 + 8 * fq;
#pragma unroll
        for (int ai = 0; ai < 2; ++ai)
#pragma unroll
            for (int m = 0; m < 4; ++m) { const size_t row = (size_t)(row0 + ai * HALF + m * 16); float s = 0.f, q = 0.f;
#pragma unroll
                for (int bj = 0; bj < 2; ++bj) { f32x4 v0 = acc[ai][bj][m][0], v1 = acc[ai][bj][m][1];
                    if (MODE == 3) {
                        unsigned w0 = 0u, w1 = 0u;
#pragma unroll
                        for (int j = 0; j < 4; j += 2) { const f32x2e s0 = sigmoid_pk((f32x2e){v0[j], v0[j + 1]}) * 255.0f, s1 = sigmoid_pk((f32x2e){v1[j], v1[j + 1]}) * 255.0f;
                            w0 = __builtin_amdgcn_cvt_pk_u8_f32(fmaxf(__builtin_rintf(s0.x), 1.0f), j, w0); w0 = __builtin_amdgcn_cvt_pk_u8_f32(fmaxf(__builtin_rintf(s0.y), 1.0f), j + 1, w0);
                            w1 = __builtin_amdgcn_cvt_pk_u8_f32(fmaxf(__builtin_rintf(s1.x), 1.0f), j, w1); w1 = __builtin_amdgcn_cvt_pk_u8_f32(fmaxf(__builtin_rintf(s1.y), 1.0f), j + 1, w1); }
                        *(u32x2v*)((unsigned char*)ZG + row * 2048 + col0 + bj * HALF) = (u32x2v){w0, w1};
                    } else {
                        if (MODE >= 1) {
#pragma unroll
                            for (int j = 0; j < 4; j += 2) { const f32x2e a = gelu_tanh_pk((f32x2e){v0[j], v0[j + 1]}), b = gelu_tanh_pk((f32x2e){v1[j], v1[j + 1]}); v0[j] = a.x; v0[j + 1] = a.y; v1[j] = b.x; v1[j + 1] = b.y; } }
                        if (MODE == 2) { s += (v0[0] + v0[1]) + (v0[2] + v0[3]) + (v1[0] + v1[1]) + (v1[2] + v1[3]);
                            q += (v0[0] * v0[0] + v0[1] * v0[1]) + (v0[2] * v0[2] + v0[3] * v0[3]) + (v1[0] * v1[0] + v1[1] * v1[1]) + (v1[2] * v1[2] + v1[3] * v1[3]); }
                        *(u32x4*)(Z4 + row * 4096 + col0 + bj * HALF) = pack8(v0, v1); } }
                if (MODE == 2) { s += __shfl_xor(s, 16); s += __shfl_xor(s, 32); q += __shfl_xor(q, 16); q += __shfl_xor(q, 32);
                    if (fq == 0) { float* p = LNS + row * 2; __hip_atomic_fetch_add(p, s, __ATOMIC_RELAXED, __HIP_MEMORY_SCOPE_AGENT); __hip_atomic_fetch_add(p + 1, q, __ATOMIC_RELAXED, __HIP_MEMORY_SCOPE_AGENT); } } }
    }
    __device__ __forceinline__ void operator()(const f32x4 (&acc)[2][2][4][2], const Unit& u, int wr, int wc, int fr, int fq) const {
        const int sec = u.pn >> 2, row0 = u.pm * BM + wr * 64 + fr;
        if (sec == 0) body<0>(acc, u.pn, row0, wc, fq);
        else if (sec < 3) body<1>(acc, u.pn, row0, wc, fq);
        else if (sec == 3) body<2>(acc, u.pn, row0, wc, fq);
        else body<3>(acc, u.pn, row0, wc, fq);
    }
};
struct EpiMerge2 {
    static constexpr bool PERM = true, AFTER_DRAIN = false, MIDK = true;
    const unsigned char* G; bf16_t* O;
    typedef unsigned u32x2v __attribute__((ext_vector_type(2)));
    static __device__ __forceinline__ f32x4 ub4(unsigned w) { return (f32x4){(float)(w & 0xffu), (float)((w >> 8) & 0xffu), (float)((w >> 16) & 0xffu), (float)(w >> 24)}; }
    __device__ __forceinline__ void mid(f32x4 (&acc)[2][2][4][2], const Unit& u, int wr, int wc, int fr, int fq) const {
        int row0 = u.pm * BM + wr * 64 + fr, col0 = u.pn * BM + wc * 32 + 8 * fq;
        asm volatile("" : "+v"(row0), "+v"(col0));
#pragma unroll
        for (int ai = 0; ai < 2; ++ai)
#pragma unroll
            for (int m = 0; m < 4; ++m) { const unsigned char* gp = G + (size_t)(row0 + ai * HALF + m * 16) * 2048 + col0;
#pragma unroll
                for (int bj = 0; bj < 2; ++bj) { const u32x2v a = __builtin_nontemporal_load((const u32x2v*)(gp + bj * HALF)), b = __builtin_nontemporal_load((const u32x2v*)(gp + 1024 + bj * HALF));
                    const f32x4 a0 = ub4(a.x), a1 = ub4(a.y), b0 = ub4(b.x), b1 = ub4(b.y);
#pragma unroll
                    for (int j = 0; j < 4; ++j) { acc[ai][bj][m][0][j] *= a0[j] * __builtin_amdgcn_rcpf(b0[j]); acc[ai][bj][m][1][j] *= a1[j] * __builtin_amdgcn_rcpf(b1[j]); }
                    asm volatile("" ::: "memory"); } }
    }
    __device__ __forceinline__ void operator()(const f32x4 (&acc)[2][2][4][2], const Unit& u, int wr, int wc, int fr, int fq) const {
        const int row0 = u.pm * BM + wr * 64 + fr, col0 = u.pn * BM + wc * 32 + 8 * fq;
        u32x2v gbv[2][4][2];
#pragma unroll
        for (int ai = 0; ai < 2; ++ai)
#pragma unroll
            for (int m = 0; m < 4; ++m)
#pragma unroll
                for (int bj = 0; bj < 2; ++bj) gbv[ai][m][bj] = *(const u32x2v*)(G + (size_t)(row0 + ai * HALF + m * 16) * 2048 + 1024 + col0 + bj * HALF);
#pragma unroll
        for (int ai = 0; ai < 2; ++ai)
#pragma unroll
            for (int m = 0; m < 4; ++m) { const size_t row = (size_t)(row0 + ai * HALF + m * 16);
#pragma unroll
                for (int bj = 0; bj < 2; ++bj) { const int c = col0 + bj * HALF; const u32x2v b = gbv[ai][m][bj];
                    const f32x4 b0 = ub4(b.x) * (1.0f / 255.0f), b1 = ub4(b.y) * (1.0f / 255.0f);
                    *(u32x4*)(O + row * 1024 + c) = pack8(acc[ai][bj][m][0] * b0, acc[ai][bj][m][1] * b1); } }
    }
};
struct EpiH1 {
    static constexpr bool PERM = true, AFTER_DRAIN = false, MIDK = false;
    const float* X; float* H; bf16_t* HB; float* SS; int wH;
    template <bool WH> __device__ __forceinline__ void body(const f32x4 (&acc)[2][2][4][2], const Unit& u, int wr, int wc, int fr, int fq) const {
        const int row0 = u.pm * BM + wr * 64 + fr, col0 = u.pn * BM + wc * 32 + 8 * fq;
#pragma unroll
        for (int ai = 0; ai < 2; ++ai)
#pragma unroll
          for (int mh = 0; mh < 4; mh += 2) {
            f32x4 xv[2][2][2];
#pragma unroll
            for (int m = 0; m < 2; ++m)
#pragma unroll
                for (int bj = 0; bj < 2; ++bj) { const float* xp = X + (size_t)(row0 + ai * HALF + (mh + m) * 16) * 1024 + col0 + bj * HALF; xv[m][bj][0] = __builtin_nontemporal_load((const f32x4*)xp); xv[m][bj][1] = __builtin_nontemporal_load((const f32x4*)(xp + 4)); }
#pragma unroll
            for (int m = 0; m < 2; ++m) { const size_t row = (size_t)(row0 + ai * HALF + (mh + m) * 16); float s = 0.f;
#pragma unroll
                for (int bj = 0; bj < 2; ++bj) { const int c = col0 + bj * HALF;
                    const f32x4 v0 = xv[m][bj][0] + acc[ai][bj][mh + m][0], v1 = xv[m][bj][1] + acc[ai][bj][mh + m][1];
                    if (WH) { *(f32x4*)(H + row * 1024 + c) = v0; *(f32x4*)(H + row * 1024 + c + 4) = v1; }
                    *(u32x4*)(HB + row * 1024 + c) = pack8(v0, v1);
                    s += (v0[0] * v0[0] + v0[1] * v0[1]) + (v0[2] * v0[2] + v0[3] * v0[3]) + (v1[0] * v1[0] + v1[1] * v1[1]) + (v1[2] * v1[2] + v1[3] * v1[3]); }
                s += __shfl_xor(s, 16); s += __shfl_xor(s, 32);
                if (fq == 0) __hip_atomic_fetch_add(SS + row, s, __ATOMIC_RELAXED, __HIP_MEMORY_SCOPE_AGENT); }
            asm volatile("" ::: "memory");
          }
    }
    __device__ __forceinline__ void operator()(const f32x4 (&acc)[2][2][4][2], const Unit& u, int wr, int wc, int fr, int fq) const {
        if (wH) body<true>(acc, u, wr, wc, fr, fq); else body<false>(acc, u, wr, wc, fr, fq);
    }
};
struct EpiUp {
    static constexpr bool PERM = true, AFTER_DRAIN = false, MIDK = false;
    const float* SS; bf16_t* U;
    __device__ __forceinline__ void operator()(const f32x4 (&acc)[2][2][4][2], const Unit& u, int wr, int wc, int fr, int fq) const {
        const int row0 = u.pm * BM + wr * 64 + fr, col0 = u.pn * BM + wc * 32 + 8 * fq;
        float ssv[2][4];
#pragma unroll
        for (int ai = 0; ai < 2; ++ai)
#pragma unroll
            for (int m = 0; m < 4; ++m) ssv[ai][m] = SS[row0 + ai * HALF + m * 16];
#pragma unroll
        for (int ai = 0; ai < 2; ++ai)
#pragma unroll
            for (int m = 0; m < 4; ++m) { const size_t row = (size_t)(row0 + ai * HALF + m * 16);
                const float rs = __builtin_amdgcn_rsqf(ssv[ai][m] * (1.0f / 1024.0f) + 1e-6f);
#pragma unroll
                for (int bj = 0; bj < 2; ++bj) { f32x4 v0 = acc[ai][bj][m][0] * rs, v1 = acc[ai][bj][m][1] * rs;
#pragma unroll
                    for (int j = 0; j < 4; ++j) { const float a = fmaxf(v0[j], 0.f), b = fmaxf(v1[j], 0.f); v0[j] = a * a; v1[j] = b * b; }
                    *(u32x4*)(U + row * 4096 + col0 + bj * HALF) = pack8(v0, v1); } }
    }
};
struct EpiDown {
    static constexpr bool PERM = false, AFTER_DRAIN = false, MIDK = false;
    float* H; float* SS;
    __device__ __forceinline__ void operator()(const f32x4 (&acc)[2][2][4][2], const Unit& u, int wr, int wc, int fr, int fq) const {
        const int row0 = u.pm * BM + wr * 64 + fr, col0 = u.pn * BM + wc * 32 + 4 * fq;
#pragma unroll
        for (int ai = 0; ai < 2; ++ai)
#pragma unroll
            for (int m = 0; m < 4; ++m) { const size_t row = (size_t)(row0 + ai * HALF + m * 16); float s = 0.f;
#pragma unroll
                for (int bj = 0; bj < 2; ++bj)
#pragma unroll
                    for (int n = 0; n < 2; ++n) { float* p = H + row * 1024 + col0 + bj * HALF + n * 16; const f32x4 v = *(const f32x4*)p + acc[ai][bj][m][n]; *(f32x4*)p = v;
                        s += (v[0] * v[0] + v[1] * v[1]) + (v[2] * v[2] + v[3] * v[3]); }
                s += __shfl_xor(s, 16); s += __shfl_xor(s, 32);
                if (fq == 0) __hip_atomic_fetch_add(SS + row, s, __ATOMIC_RELAXED, __HIP_MEMORY_SCOPE_AGENT); }
    }
};

struct EpiDownNorm {
    static constexpr bool PERM = true, AFTER_DRAIN = true, MIDK = false;
    const bf16_t* HB; float* OUT; float* SS; unsigned* CNT; const float* g;
    __device__ __forceinline__ void fused(f32x4 (&acc)[2][2][4][2], const Unit& u, int wr, int wc, int fr, int fq, PG8_LAS unsigned char* lds, int wid, int lane) const {
        const int row0 = u.pm * BM + wr * 64 + fr, col0 = u.pn * BM + wc * 32 + 8 * fq;
        u32x4 hbv[2][4][2];
#pragma unroll
        for (int ai = 0; ai < 2; ++ai)
#pragma unroll
            for (int m = 0; m < 4; ++m)
#pragma unroll
                for (int bj = 0; bj < 2; ++bj) hbv[ai][m][bj] = *(const u32x4*)(HB + (size_t)(row0 + ai * HALF + m * 16) * 1024 + col0 + bj * HALF);
        float old8[2][4];
#pragma unroll
        for (int ai = 0; ai < 2; ++ai)
#pragma unroll
            for (int m = 0; m < 4; ++m) { const size_t row = (size_t)(row0 + ai * HALF + m * 16); float s = 0.f;
#pragma unroll
                for (int bj = 0; bj < 2; ++bj) { const u32x4 hb = hbv[ai][m][bj];
                    const f32x4 v0 = (f32x4){bf_lo(hb.x), bf_hi(hb.x), bf_lo(hb.y), bf_hi(hb.y)} + acc[ai][bj][m][0], v1 = (f32x4){bf_lo(hb.z), bf_hi(hb.z), bf_lo(hb.w), bf_hi(hb.w)} + acc[ai][bj][m][1];
                    acc[ai][bj][m][0] = v0; acc[ai][bj][m][1] = v1;
                    s += (v0[0] * v0[0] + v0[1] * v0[1]) + (v0[2] * v0[2] + v0[3] * v0[3]) + (v1[0] * v1[0] + v1[1] * v1[1]) + (v1[2] * v1[2] + v1[3] * v1[3]); }
                s += __shfl_xor(s, 16); s += __shfl_xor(s, 32);
                old8[ai][m] = (fq == 0) ? __hip_atomic_fetch_add(SS + row, s, __ATOMIC_RELAXED, __HIP_MEMORY_SCOPE_AGENT) : 0.f; }
        asm volatile("s_waitcnt vmcnt(0)" :: "v"(old8[0][0]), "v"(old8[0][1]), "v"(old8[0][2]), "v"(old8[0][3]), "v"(old8[1][0]), "v"(old8[1][1]), "v"(old8[1][2]), "v"(old8[1][3]) : "memory");
        __syncthreads();
        if (threadIdx.x == 0) {
            unsigned* c = CNT + 64 * u.pm;
            __hip_atomic_fetch_add(c, 1u, __ATOMIC_RELAXED, __HIP_MEMORY_SCOPE_AGENT);
            unsigned sp = 0u;
            while (__hip_atomic_load(c, __ATOMIC_RELAXED, __HIP_MEMORY_SCOPE_AGENT) < 4u) { __builtin_amdgcn_s_sleep(1); if (++sp > (1u << 22)) break; }
            __builtin_amdgcn_fence(__ATOMIC_ACQUIRE, "agent");
            asm volatile("s_waitcnt vmcnt(0)" ::: "memory");
        }
        __syncthreads();
        f32x4 gv[2][2]; float ssv[2][4];
#pragma unroll
        for (int bj = 0; bj < 2; ++bj)
#pragma unroll
            for (int n = 0; n < 2; ++n) gv[bj][n] = *(const f32x4*)(g + col0 + bj * HALF + 4 * n);
#pragma unroll
        for (int ai = 0; ai < 2; ++ai)
#pragma unroll
            for (int m = 0; m < 4; ++m) ssv[ai][m] = __hip_atomic_load(SS + (size_t)(row0 + ai * HALF + m * 16), __ATOMIC_RELAXED, __HIP_MEMORY_SCOPE_AGENT);
#pragma unroll
        for (int ai = 0; ai < 2; ++ai)
#pragma unroll
            for (int m = 0; m < 4; ++m) { const size_t row = (size_t)(row0 + ai * HALF + m * 16);
                const float rs = __builtin_amdgcn_rsqf(ssv[ai][m] * (1.0f / 1024.0f) + 1e-6f);
#pragma unroll
                for (int bj = 0; bj < 2; ++bj)
#pragma unroll
                    for (int n = 0; n < 2; ++n) *(f32x4*)(OUT + row * 1024 + col0 + bj * HALF + 4 * n) = acc[ai][bj][m][n] * rs * gv[bj][n]; }
    }
};
template <class Epi, class Sched, bool ALIGN_EPI = false, bool SP2 = false>
__device__ __forceinline__ void gemm_phase(PG8_LAS unsigned char* lds, const Gemm g, const Sched& S, const Epi& E) {
    int tid_ = threadIdx.x; asm volatile("" : "+v"(tid_));
    const int tid = tid_, wid = __builtin_amdgcn_readfirstlane(tid >> 6), lane = tid & 63, wr = wid >> 2, wc = wid & 3, fr = lane & 15, fq = lane >> 4;
    const int K = g.K, nt = K / BK;
    unsigned voffA[2], voffB[2];
#pragma unroll
    for (int i = 0; i < 2; ++i) { int R, C; stage_rc(tid * 16 + i * 8192, R, C); const int Rb = Epi::PERM ? ((R & ~31) + perm32(R & 31)) : R;
        voffA[i] = (unsigned)(R * K + C) * 2u; voffB[i] = (unsigned)(Rb * K + C) * 2u; }
    const size_t kstep = (size_t)(BK * 2);
    const size_t hstep = (size_t)HALF * K * 2;
    const size_t tstep = 2 * hstep;
    const unsigned ldsw = (unsigned)wid * 1024u;
    const int aoff = lds_byte(wr * 64 + fr, fq * 8), boff = lds_byte(wc * 32 + fr, fq * 8);
#define PG8_SA(b, h) (((b) * 2 + (h)) * HTB)
#define PG8_SB(b, h) ((4 + (b) * 2 + (h)) * HTB)
#define PG8_STAGE(bufoff, gbase, voff) do { _Pragma("unroll") for (int _i = 0; _i < 2; ++_i) \
        __builtin_amdgcn_global_load_lds((const unsigned*)((const char*)(gbase) + (voff)[_i]), (PG8_LAS unsigned*)(lds + (bufoff) + ldsw + _i * 8192), 16, 0, 0); } while (0)
#define PG8_LDA(dst, b, h) do { _Pragma("unroll") for (int m = 0; m < 4; ++m) _Pragma("unroll") for (int k = 0; k < 2; ++k) dst[m][k] = *(const PG8_LAS bf16x8*)(lds + PG8_SA(b, h) + aoff + m * 2048 + k * 1024); } while (0)
#define PG8_LDB(dst, b, h) do { _Pragma("unroll") for (int n = 0; n < 2; ++n) _Pragma("unroll") for (int k = 0; k < 2; ++k) dst[n][k] = *(const PG8_LAS bf16x8*)(lds + PG8_SB(b, h) + boff + n * 2048 + k * 1024); } while (0)
#define PG8_MMA(ai, bj, At, Bt) do { __builtin_amdgcn_s_setprio(1); _Pragma("unroll") for (int m = 0; m < 4; ++m) _Pragma("unroll") for (int n = 0; n < 2; ++n) _Pragma("unroll") for (int k = 0; k < 2; ++k) \
        acc[ai][bj][m][n] = __builtin_amdgcn_mfma_f32_16x16x32_bf16(Bt[n][k], At[m][k], acc[ai][bj][m][n], 0, 0, 0); __builtin_amdgcn_s_setprio(0); } while (0)
#define PG8_WAIT_V(n) asm volatile("s_waitcnt vmcnt(" #n ")" ::: "memory")
#define PG8_WAIT_L(n) asm volatile("s_waitcnt lgkmcnt(" #n ")" ::: "memory")
#define PG8_BAR __builtin_amdgcn_s_barrier()
#define PG8_SCHED __builtin_amdgcn_sched_barrier(0)
    Unit cur, nxt; int ui = 0;
    if (!S.next(0, cur)) return;
    f32x4 acc[2][2][4][2];
#pragma unroll
    for (int a = 0; a < 2; ++a)
#pragma unroll
        for (int b = 0; b < 2; ++b)
#pragma unroll
            for (int m = 0; m < 4; ++m)
#pragma unroll
                for (int n = 0; n < 2; ++n) acc[a][b][m][n] = (f32x4){0.f, 0.f, 0.f, 0.f};
    bf16x8 At[4][2], B0[2][2], B1[2][2];
    const char* cA = (const char*)g.A + (size_t)cur.pm * tstep; const char* cB = (const char*)g.Bt + (size_t)cur.pn * tstep;
    S.a_ready(cur);
    if constexpr (SP2) {
        PG8_STAGE(PG8_SB(0, 0), cB, voffB); PG8_STAGE(PG8_SB(0, 1), cB + hstep, voffB); PG8_STAGE(PG8_SA(0, 0), cA, voffA); PG8_STAGE(PG8_SA(0, 1), cA + hstep, voffA);
        if (wr == 1) PG8_BAR;
        PG8_WAIT_V(2); PG8_BAR;
        PG8_STAGE(PG8_SB(1, 0), cB + kstep, voffB); PG8_STAGE(PG8_SA(1, 0), cA + kstep, voffA); PG8_STAGE(PG8_SB(1, 1), cB + hstep + kstep, voffB);
        PG8_WAIT_V(6); PG8_BAR;
    } else {
        PG8_STAGE(PG8_SB(0, 0), cB, voffB); PG8_STAGE(PG8_SA(0, 0), cA, voffA); PG8_STAGE(PG8_SB(0, 1), cB + hstep, voffB); PG8_STAGE(PG8_SA(0, 1), cA + hstep, voffA);
        if (wr == 1) PG8_BAR;
        PG8_WAIT_V(4); PG8_BAR;
        PG8_STAGE(PG8_SB(1, 0), cB + kstep, voffB); PG8_STAGE(PG8_SA(1, 0), cA + kstep, voffA); PG8_STAGE(PG8_SB(1, 1), cB + hstep + kstep, voffB);
        PG8_WAIT_V(6); PG8_BAR;
    }
    for (;;) {
        const bool has_next = S.next(ui + 1, nxt);
        const char* nA = has_next ? (const char*)g.A + (size_t)nxt.pm * tstep : cA; const char* nB = has_next ? (const char*)g.Bt + (size_t)nxt.pn * tstep : cB;
        for (int t = 0; t < nt; t += 2) {
            const bool last = (t == nt - 2);
            const char* a1 = cA + (size_t)(t + 1) * kstep;
            const char* a2 = last ? nA : cA + (size_t)(t + 2) * kstep; const char* b2 = last ? nB : cB + (size_t)(t + 2) * kstep;
            const char* a3 = a2 + kstep; const char* b3 = b2 + kstep;
            if (last && has_next) S.a_ready(nxt);
            if constexpr (Epi::MIDK) { if (t == (nt >> 1)) E.mid(acc, cur, wr, wc, fr, fq); }
            if constexpr (SP2) {
            PG8_LDB(B0, 0, 0); PG8_LDB(B1, 0, 1); PG8_SCHED; PG8_LDA(At, 0, 0); PG8_STAGE(PG8_SA(1, 1), a1 + hstep, voffA);
            PG8_WAIT_V(8); PG8_WAIT_L(0); PG8_BAR; PG8_MMA(0, 0, At, B0); PG8_MMA(0, 1, At, B1); PG8_BAR; PG8_SCHED;
            PG8_LDA(At, 0, 1); PG8_STAGE(PG8_SB(0, 0), b2, voffB); PG8_STAGE(PG8_SB(0, 1), b2 + hstep, voffB); PG8_STAGE(PG8_SA(0, 0), a2, voffA);
            PG8_WAIT_V(8); PG8_WAIT_L(0); PG8_BAR; PG8_MMA(1, 0, At, B0); PG8_MMA(1, 1, At, B1); PG8_BAR; PG8_SCHED;
            PG8_LDB(B0, 1, 0); PG8_LDB(B1, 1, 1); PG8_SCHED; PG8_LDA(At, 1, 0); PG8_STAGE(PG8_SA(0, 1), a2 + hstep, voffA);
            PG8_WAIT_V(8); PG8_WAIT_L(0); PG8_BAR; PG8_MMA(0, 0, At, B0); PG8_MMA(0, 1, At, B1); PG8_BAR; PG8_SCHED;
            PG8_LDA(At, 1, 1); PG8_STAGE(PG8_SB(1, 0), b3, voffB); PG8_STAGE(PG8_SB(1, 1), b3 + hstep, voffB); PG8_STAGE(PG8_SA(1, 0), a3, voffA);
            PG8_WAIT_V(8); PG8_WAIT_L(0); PG8_BAR; PG8_MMA(1, 0, At, B0); PG8_MMA(1, 1, At, B1); PG8_BAR; PG8_SCHED;
            } else {
            PG8_LDB(B0, 0, 0); PG8_SCHED; PG8_LDA(At, 0, 0); PG8_STAGE(PG8_SA(1, 1), a1 + hstep, voffA);
            PG8_WAIT_L(8); PG8_BAR; PG8_WAIT_L(0); PG8_MMA(0, 0, At, B0); PG8_BAR; PG8_SCHED;
            PG8_LDB(B1, 0, 1); PG8_STAGE(PG8_SB(0, 0), b2, voffB);
            PG8_BAR; PG8_WAIT_L(0); PG8_MMA(0, 1, At, B1); PG8_BAR;
            PG8_LDA(At, 0, 1); PG8_STAGE(PG8_SA(0, 0), a2, voffA);
            PG8_BAR; PG8_WAIT_L(0); PG8_MMA(1, 0, At, B0); PG8_BAR; PG8_SCHED;
            PG8_STAGE(PG8_SB(0, 1), b2 + hstep, voffB);
            PG8_WAIT_V(6); PG8_BAR; PG8_MMA(1, 1, At, B1); PG8_BAR;
            PG8_LDB(B0, 1, 0); PG8_SCHED; PG8_LDA(At, 1, 0); PG8_STAGE(PG8_SA(0, 1), a2 + hstep, voffA);
            PG8_WAIT_L(8); PG8_BAR; PG8_WAIT_L(0); PG8_MMA(0, 0, At, B0); PG8_BAR; PG8_SCHED;
            PG8_LDB(B1, 1, 1); PG8_STAGE(PG8_SB(1, 0), b3, voffB);
            PG8_BAR; PG8_WAIT_L(0); PG8_MMA(0, 1, At, B1); PG8_BAR;
            PG8_LDA(At, 1, 1); PG8_STAGE(PG8_SA(1, 0), a3, voffA);
            PG8_BAR; PG8_WAIT_L(0); PG8_MMA(1, 0, At, B0); PG8_BAR; PG8_SCHED;
            PG8_STAGE(PG8_SB(1, 1), b3 + hstep, voffB);
            PG8_WAIT_V(6); PG8_BAR; PG8_MMA(1, 1, At, B1); PG8_BAR;
            }
        }
        if constexpr (ALIGN_EPI) { if (wr == 0) PG8_BAR; }
        if constexpr (!Epi::AFTER_DRAIN) { E(acc, cur, wr, wc, fr, fq); S.done(cur); }
        if (!has_next) break;
#pragma unroll
        for (int a = 0; a < 2; ++a)
#pragma unroll
            for (int b = 0; b < 2; ++b)
#pragma unroll
                for (int m = 0; m < 4; ++m)
#pragma unroll
                    for (int n = 0; n < 2; ++n) acc[a][b][m][n] = (f32x4){0.f, 0.f, 0.f, 0.f};
        cur = nxt; cA = nA; cB = nB; ++ui;
        if constexpr (ALIGN_EPI) { if (wr == 1) PG8_BAR; }
    }
    PG8_WAIT_V(0);
    if constexpr (!ALIGN_EPI) { if (wr == 0) PG8_BAR; }
    PG8_BAR;
    if constexpr (Epi::AFTER_DRAIN) { E.fused(acc, cur, wr, wc, fr, fq, lds, wid, lane); S.done(cur); }
#undef PG8_SA
#undef PG8_SB
#undef PG8_STAGE
#undef PG8_LDA
#undef PG8_LDB
#undef PG8_MMA
#undef PG8_WAIT_V
#undef PG8_WAIT_L
#undef PG8_BAR
#undef PG8_SCHED
}
}
using pg8::bf16_t; using pg8::bf16x8; using pg8::f32x4; using pg8::u32x4; using pg8::cvt_pk_bf16; using pg8::bf_lo; using pg8::bf_hi; using pg8::pack8; using pg8::sigmoid_f;
constexpr int SEQ = 4096, NB = 4, DM = 1024, MTOK = NB * SEQ, DIN = 6144, DFF = 4096, NCHUNK = 32;
constexpr size_t MiB = 1u << 20;
constexpr size_t WS_WIN = 0, WS_WOA = 12 * MiB, WS_WOB = 14 * MiB, WS_WOUT = 16 * MiB, WS_WUP = 18 * MiB, WS_WDN = 26 * MiB, WS_WG = 34 * MiB, WS_WSM = 35 * MiB;
constexpr size_t WS_SUMA = 35 * MiB + 512 * 1024, WS_SUMB = 36 * MiB, WS_LNST = 36 * MiB + 512 * 1024, WS_SS1 = WS_LNST + 128 * 1024, WS_SS2 = WS_SS1 + 64 * 1024;
constexpr size_t WS_Z4 = 38 * MiB;
constexpr size_t WS_TMP = WS_Z4, WS_MRG = WS_Z4 + 64 * MiB, WS_U = WS_Z4;
constexpr size_t WS_XN = 166 * MiB;
constexpr size_t WS_YA = WS_XN, WS_H1B = WS_XN, WS_YB = 198 * MiB, WS_END = 230 * MiB;
constexpr size_t WS_BAR = 37 * MiB;
constexpr int LDS_BYTES = 144 * 1024;

struct Params { const float* in[21]; float* out; unsigned char* ws; };

typedef float f32x2 __attribute__((ext_vector_type(2)));
__device__ __forceinline__ float wave_sum(float v) {
#pragma unroll
    for (int o = 1; o < 64; o <<= 1) v += __shfl_xor(v, o);
    return v;
}
__device__ __forceinline__ void tr_item(const float* __restrict__ W, int N, int K, bf16_t* __restrict__ WT, const float* __restrict__ ks, float* scr, int item, int lane, int ldk = 0) {
    if (ldk == 0) ldk = K;
    const int nblk = N / 32, kb = item / nblk, nb = item % nblk, k0 = 64 * kb, n0 = 32 * nb;
#pragma unroll 8
    for (int i = 0; i < 32; ++i) { const int kk = 2 * i + (lane >> 5); scr[kk * 33 + (lane & 31)] = __builtin_nontemporal_load(W + (size_t)(k0 + kk) * N + n0 + (lane & 31)); }
    asm volatile("s_waitcnt lgkmcnt(0)" ::: "memory");
    const int c = lane & 7;
    f32x4 s0 = {1.f, 1.f, 1.f, 1.f}, s1 = {1.f, 1.f, 1.f, 1.f};
    if (ks) { s0 = *(const f32x4*)(ks + k0 + 8 * c); s1 = *(const f32x4*)(ks + k0 + 8 * c + 4); }
#pragma unroll
    for (int j = 0; j < 4; ++j) { const int n = (lane >> 3) + 8 * j; const float* s = scr + (8 * c) * 33 + n;
        u32x4 o; o.x = cvt_pk_bf16(s[0 * 33] * s0[0], s[1 * 33] * s0[1]); o.y = cvt_pk_bf16(s[2 * 33] * s0[2], s[3 * 33] * s0[3]); o.z = cvt_pk_bf16(s[4 * 33] * s1[0], s[5 * 33] * s1[1]); o.w = cvt_pk_bf16(s[6 * 33] * s1[2], s[7 * 33] * s1[3]);
        *(u32x4*)(WT + (size_t)(n0 + n) * ldk + k0 + 8 * c) = o; }
    asm volatile("s_waitcnt lgkmcnt(0)" ::: "memory");
}
__device__ __forceinline__ void rms_row_to_bf16(const float* __restrict__ xrow, const float* __restrict__ g, bf16_t* __restrict__ orow, int lane) {
    const f32x4* xr = (const f32x4*)xrow + lane; const f32x4* gr = (const f32x4*)g + lane;
    f32x4 v[4]; float s = 0.f;
#pragma unroll
    for (int j = 0; j < 4; ++j) { v[j] = xr[64 * j]; s += (v[j][0] * v[j][0] + v[j][1] * v[j][1]) + (v[j][2] * v[j][2] + v[j][3] * v[j][3]); }
    const float rs = 1.0f / sqrtf(wave_sum(s) * (1.0f / 1024.0f) + 1e-6f);
    unsigned long long* o8 = (unsigned long long*)orow + lane;
#pragma unroll
    for (int j = 0; j < 4; ++j) { const f32x4 gg = gr[64 * j]; const f32x4 y = v[j] * rs * gg;
        o8[64 * j] = (unsigned long long)cvt_pk_bf16(y[0], y[1]) | ((unsigned long long)cvt_pk_bf16(y[2], y[3]) << 32); }
}
__device__ __forceinline__ void rms_rows2_to_bf16(const float* __restrict__ xa, const float* __restrict__ xb, const float* __restrict__ g, bf16_t* __restrict__ oa, bf16_t* __restrict__ ob, int lane) {
    const f32x4* ra = (const f32x4*)xa + lane; const f32x4* rb = (const f32x4*)xb + lane; const f32x4* gr = (const f32x4*)g + lane;
    f32x4 va[4], vb[4], gg[4]; float sa = 0.f, sb = 0.f;
#pragma unroll
    for (int j = 0; j < 4; ++j) { va[j] = __builtin_nontemporal_load(ra + 64 * j); vb[j] = __builtin_nontemporal_load(rb + 64 * j); gg[j] = gr[64 * j]; }
#pragma unroll
    for (int j = 0; j < 4; ++j) { sa += (va[j][0] * va[j][0] + va[j][1] * va[j][1]) + (va[j][2] * va[j][2] + va[j][3] * va[j][3]); sb += (vb[j][0] * vb[j][0] + vb[j][1] * vb[j][1]) + (vb[j][2] * vb[j][2] + vb[j][3] * vb[j][3]); }
#pragma unroll
    for (int o = 1; o < 64; o <<= 1) { sa += __shfl_xor(sa, o); sb += __shfl_xor(sb, o); }
    const float rsa = 1.0f / sqrtf(sa * (1.0f / 1024.0f) + 1e-6f), rsb = 1.0f / sqrtf(sb * (1.0f / 1024.0f) + 1e-6f);
    unsigned long long* pa = (unsigned long long*)oa + lane; unsigned long long* pb = (unsigned long long*)ob + lane;
#pragma unroll
    for (int j = 0; j < 4; ++j) { const f32x4 ya = va[j] * rsa * gg[j], yb = vb[j] * rsb * gg[j];
        pa[64 * j] = (unsigned long long)cvt_pk_bf16(ya[0], ya[1]) | ((unsigned long long)cvt_pk_bf16(ya[2], ya[3]) << 32);
        pb[64 * j] = (unsigned long long)cvt_pk_bf16(yb[0], yb[1]) | ((unsigned long long)cvt_pk_bf16(yb[2], yb[3]) << 32); }
}
__device__ __forceinline__ void unpack8(const u32x4 w, float (&f)[8]) { f[0] = bf_lo(w.x); f[1] = bf_hi(w.x); f[2] = bf_lo(w.y); f[3] = bf_hi(w.y); f[4] = bf_lo(w.z); f[5] = bf_hi(w.z); f[6] = bf_lo(w.w); f[7] = bf_hi(w.w); }
__device__ __forceinline__ float bf16_to_f(bf16_t h) { return __uint_as_float(((unsigned)h) << 16); }
__device__ __forceinline__ bf16_t f_to_bf16(float f) { return (bf16_t)(cvt_pk_bf16(f, 0.f) & 0xffffu); }

struct Ctx {
    const float* in[21]; float* out; unsigned char* ws;
    bf16_t *WIN, *WOA, *WOB, *WOUT, *WUP, *WDN, *WG, *WSM, *Z4, *ZG, *XN, *YA, *YB, *MRG, *H1B, *U;
    float *SUMA, *SUMB, *LNST, *SS1, *SS2, *TMP; unsigned* MASK;
};

constexpr int XC_LD = 264;
__device__ __forceinline__ void mixer_a_tile(unsigned char* lds, const Ctx& C, int tile) {
    int tid_ = threadIdx.x; asm volatile("" : "+v"(tid_));
    const int tid = tid_, lane = tid & 63, wave = tid >> 6, fr = lane & 15, fq = lane >> 4;
    const int h = tile & 3, ck = (tile >> 2) & 31, b = tile >> 7;
    const size_t row_base = (size_t)b * SEQ + (size_t)ck * 128;
    bf16_t* XC = (bf16_t*)lds;
    bf16_t* HB = (bf16_t*)(lds + 67584);
    float* H0 = (float*)(lds + 135168);
    const bf16_t* wgr = C.WG + ((size_t)(h * 2 + 0) * 256 + 32 * wave + fr) * 256 + 8 * fq;
    bf16x8 gf[4][4];
#pragma unroll
    for (int k = 0; k < 3; ++k) { gf[k][0] = *(const bf16x8*)(wgr + k * 32); gf[k][1] = *(const bf16x8*)(wgr + 4096 + k * 32); gf[k][2] = *(const bf16x8*)(wgr + 65536 + k * 32); gf[k][3] = *(const bf16x8*)(wgr + 65536 + 4096 + k * 32); }
    {
        const int cc = tid & 31, tg = tid >> 5, ch0 = h * 256 + cc * 8;
        const float* cw = C.in[3]; const float* cbp = C.in[4];
        float w[4][8], cb[8];
#pragma unroll
        for (int k = 0; k < 4; ++k) { const f32x4 w0 = *(const f32x4*)(cw + k * DM + ch0), w1 = *(const f32x4*)(cw + k * DM + ch0 + 4);
#pragma unroll
            for (int j = 0; j < 4; ++j) { w[k][j] = w0[j]; w[k][4 + j] = w1[j]; } }
        { const f32x4 b0 = *(const f32x4*)(cbp + ch0), b1 = *(const f32x4*)(cbp + ch0 + 4);
#pragma unroll
          for (int j = 0; j < 4; ++j) { cb[j] = b0[j]; cb[4 + j] = b1[j]; } }
        u32x4 xr[11];
#pragma unroll
        for (int tt = 0; tt < 11; ++tt) { const int tl = tg * 8 - 3 + tt; const int tglob = ck * 128 + tl;
            xr[tt] = (tglob >= 0) ? __builtin_nontemporal_load((const u32x4*)(C.Z4 + ((size_t)b * SEQ + tglob) * 4096 + ch0)) : (u32x4){0u, 0u, 0u, 0u}; }
#pragma unroll
        for (int t = 0; t < 8; ++t) { float o[8];
#pragma unroll
            for (int j = 0; j < 8; ++j) o[j] = cb[j];
#pragma unroll
            for (int k = 0; k < 4; ++k) { float x[8]; unpack8(xr[t + 3 - k], x);
#pragma unroll
                for (int j = 0; j < 8; ++j) o[j] += w[k][j] * x[j]; }
            u32x4 pk; pk.x = cvt_pk_bf16(o[0], o[1]); pk.y = cvt_pk_bf16(o[2], o[3]); pk.z = cvt_pk_bf16(o[4], o[5]); pk.w = cvt_pk_bf16(o[6], o[7]);
            *(u32x4*)(XC + (tg * 8 + t) * XC_LD + cc * 8) = pk; }
    }
    __syncthreads();
    f32x4 accr[2][8], acci[2][8];
#pragma unroll
    for (int n = 0; n < 2; ++n)
#pragma unroll
        for (int m = 0; m < 8; ++m) { accr[n][m] = (f32x4){0.f, 0.f, 0.f, 0.f}; acci[n][m] = (f32x4){0.f, 0.f, 0.f, 0.f}; }
    {
        const bf16_t* xa = XC + fr * XC_LD + 8 * fq;
#pragma unroll
        for (int ks = 0; ks < 8; ++ks) {
            if (ks + 3 < 8) { const bf16_t* wn = wgr + (ks + 3) * 32; bf16x8* d = gf[(ks + 3) % 4];
                d[0] = *(const bf16x8*)(wn); d[1] = *(const bf16x8*)(wn + 4096); d[2] = *(const bf16x8*)(wn + 65536); d[3] = *(const bf16x8*)(wn + 65536 + 4096); }
            const bf16x8* cf = gf[ks % 4];
#pragma unroll
            for (int m = 0; m < 8; ++m) { const bf16x8 a = *(const bf16x8*)(xa + m * 16 * XC_LD + ks * 32);
                accr[0][m] = __builtin_amdgcn_mfma_f32_16x16x32_bf16(a, cf[0], accr[0][m], 0, 0, 0);
                accr[1][m] = __builtin_amdgcn_mfma_f32_16x16x32_bf16(a, cf[1], accr[1][m], 0, 0, 0);
                acci[0][m] = __builtin_amdgcn_mfma_f32_16x16x32_bf16(a, cf[2], acci[0][m], 0, 0, 0);
                acci[1][m] = __builtin_amdgcn_mfma_f32_16x16x32_bf16(a, cf[3], acci[1][m], 0, 0, 0); }
            asm volatile("" ::: "memory");
        }
    }
#pragma unroll
    for (int n = 0; n < 2; ++n) {
        const int chl = 32 * wave + 16 * n + fr, ch = h * 256 + chl;
        const float brv = C.in[6][ch], biv = C.in[8][ch], lam = C.in[9][ch];
        const float sp8 = -8.0f * (fmaxf(-lam, 0.f) + log1pf(__expf(-fabsf(lam))));
        const float sp8l2 = sp8 * 1.4426950409f, sp16 = 2.0f * sp8; const float nbr = -1.4426950409f * brv, nbi = -1.4426950409f * biv;
        float hc = 0.f, Ac = 1.f;
#pragma unroll
        for (int m = 0; m < 8; ++m) {
            float a[4], bx[4];
#pragma unroll
            for (int hh = 0; hh < 2; ++hh) {
                const int t = 16 * m + 4 * fq + 2 * hh;
                const f32x2 xcv = {bf16_to_f(XC[t * XC_LD + chl]), bf16_to_f(XC[(t + 1) * XC_LD + chl])};
                const f32x2 pr = {accr[n][m][2 * hh], accr[n][m][2 * hh + 1]}, pi = {acci[n][m][2 * hh], acci[n][m][2 * hh + 1]};
                f32x2 xr = pr * (-1.4426950409f) + nbr, xi = pi * (-1.4426950409f) + nbi;
                xr.x = fminf(xr.x, 60.f); xr.y = fminf(xr.y, 60.f); xi.x = fminf(xi.x, 60.f); xi.y = fminf(xi.y, 60.f);
                f32x2 er, ei; er.x = __builtin_amdgcn_exp2f(xr.x); er.y = __builtin_amdgcn_exp2f(xr.y); ei.x = __builtin_amdgcn_exp2f(xi.x); ei.y = __builtin_amdgcn_exp2f(xi.y);
                const f32x2 dr = er + 1.0f, di = ei + 1.0f, dd = dr * di;
                f32x2 inv; inv.x = __builtin_amdgcn_rcpf(dd.x); inv.y = __builtin_amdgcn_rcpf(dd.y);
                const f32x2 r = di * inv, ig = dr * inv;
                const f32x2 l2 = r * sp8l2;
                f32x2 av; av.x = __builtin_amdgcn_exp2f(l2.x); av.y = __builtin_amdgcn_exp2f(l2.y);
                const f32x2 x2 = r * sp16;
                f32x2 q = x2 * 0.0013888889f + 0.0083333338f; q = q * x2 + 0.041666668f; q = q * x2 + 0.16666667f; q = q * x2 + 0.5f; q = q * x2 + 1.0f;
                const f32x2 ser = -x2 * q, dir = 1.0f - av * av;
                f32x2 m2; m2.x = fmaxf((x2.x > -0.25f) ? ser.x : dir.x, 0.f); m2.y = fmaxf((x2.y > -0.25f) ? ser.y : dir.y, 0.f);
                f32x2 mu; mu.x = __builtin_amdgcn_sqrtf(m2.x); mu.y = __builtin_amdgcn_sqrtf(m2.y);
                const f32x2 bxx = xcv * ig * mu;
                a[2 * hh] = av.x; a[2 * hh + 1] = av.y; bx[2 * hh] = bxx.x; bx[2 * hh + 1] = bxx.y;
            }
            const float p0 = a[0], h0l = bx[0];
            const float p1 = p0 * a[1], h1l = h0l * a[1] + bx[1];
            const float p2 = p1 * a[2], h2l = h1l * a[2] + bx[2];
            const float p3 = p2 * a[3], h3l = h2l * a[3] + bx[3];
            float Ai = p3, Bi = h3l;
            float At = __shfl_up(Ai, 16), Bt = __shfl_up(Bi, 16);
            if (fq >= 1) { Bi = Bt * Ai + Bi; Ai = At * Ai; }
            At = __shfl_up(Ai, 32); Bt = __shfl_up(Bi, 32);
            if (fq >= 2) { Bi = Bt * Ai + Bi; Ai = At * Ai; }
            const float Am = __shfl(Ai, 48 + fr), Bm = __shfl(Bi, 48 + fr);
            float Ae = __shfl_up(Ai, 16), Be = __shfl_up(Bi, 16);
            if (fq == 0) { Ae = 1.f; Be = 0.f; }
            const float hin = Be + Ae * hc, Pin = Ae * Ac;
            accr[n][m] = (f32x4){Pin * p0, Pin * p1, Pin * p2, Pin * p3};
            acci[n][m] = (f32x4){h0l + p0 * hin, h1l + p1 * hin, h2l + p2 * hin, h3l + p3 * hin};
            hc = hc * Am + Bm; Ac *= Am;
        }
        if (fq == 0) { const size_t o = ((size_t)(b * NCHUNK + ck)) * DM + ch;
            __hip_atomic_store(C.SUMA + o, Ac, __ATOMIC_RELAXED, __HIP_MEMORY_SCOPE_AGENT); __hip_atomic_store(C.SUMB + o, hc, __ATOMIC_RELAXED, __HIP_MEMORY_SCOPE_AGENT); }
    }
    asm volatile("s_waitcnt vmcnt(0)" ::: "memory");
    __syncthreads();
    if (tid == 0) {
        unsigned* mk = C.MASK + 64 * (b * 4 + h);
        __hip_atomic_fetch_or(mk, 1u << ck, __ATOMIC_RELAXED, __HIP_MEMORY_SCOPE_AGENT);
        const unsigned need = (1u << ck) - 1u; unsigned sp = 0u;
        while ((__hip_atomic_load(mk, __ATOMIC_RELAXED, __HIP_MEMORY_SCOPE_AGENT) & need) != need) { __builtin_amdgcn_s_sleep(1); if (++sp > (1u << 22)) break; }
        __builtin_amdgcn_fence(__ATOMIC_ACQUIRE, "agent");
        asm volatile("s_waitcnt vmcnt(0)" ::: "memory");
    }
    __syncthreads();
    if (tid < 256) {
        const int ch = h * 256 + tid; float hcar = 0.f;
        for (int c2 = 0; c2 < ck; c2 += 8) { float a[8], bb[8];
#pragma unroll
            for (int j = 0; j < 8; ++j) { const bool ok = (c2 + j) < ck; const size_t o = ((size_t)(b * NCHUNK + (ok ? c2 + j : 0))) * DM + ch;
                a[j] = ok ? __hip_atomic_load(C.SUMA + o, __ATOMIC_RELAXED, __HIP_MEMORY_SCOPE_AGENT) : 1.f; bb[j] = ok ? __hip_atomic_load(C.SUMB + o, __ATOMIC_RELAXED, __HIP_MEMORY_SCOPE_AGENT) : 0.f; }
#pragma unroll
            for (int j = 0; j < 8; ++j) hcar = hcar * a[j] + bb[j]; }
        H0[tid] = hcar;
    }
    __syncthreads();
#pragma unroll
    for (int n = 0; n < 2; ++n) { const int chl = 32 * wave + 16 * n + fr; const float h0 = H0[chl];
#pragma unroll
        for (int m = 0; m < 8; ++m)
#pragma unroll
            for (int i = 0; i < 4; ++i) HB[(16 * m + 4 * fq + i) * XC_LD + chl] = f_to_bf16(acci[n][m][i] + accr[n][m][i] * h0); }
    __syncthreads();
    {
        const int cc = tid & 31, tg = tid >> 5;
#pragma unroll
        for (int t4 = 0; t4 < 8; t4 += 4) {
        u32x4 gav[4];
#pragma unroll
        for (int tt = 0; tt < 4; ++tt) gav[tt] = __builtin_nontemporal_load((const u32x4*)(C.Z4 + (row_base + tg * 8 + t4 + tt) * 4096 + 1024 + h * 256 + cc * 8));
#pragma unroll
        for (int tt = 0; tt < 4; ++tt) { const int t = tg * 8 + t4 + tt;
            float hv[8], gv[8]; unpack8(*(const u32x4*)(HB + t * XC_LD + cc * 8), hv); unpack8(gav[tt], gv);
            u32x4 pk; pk.x = cvt_pk_bf16(hv[0] * gv[0], hv[1] * gv[1]); pk.y = cvt_pk_bf16(hv[2] * gv[2], hv[3] * gv[3]); pk.z = cvt_pk_bf16(hv[4] * gv[4], hv[5] * gv[5]); pk.w = cvt_pk_bf16(hv[6] * gv[6], hv[7] * gv[7]);
            *(u32x4*)(C.YA + (row_base + t) * 2048 + h * 256 + cc * 8) = pk; }
        asm volatile("" ::: "memory"); }
    }
    __syncthreads();
}

constexpr int WS_LD = 136;
__device__ __forceinline__ void mixer_b_tile(unsigned char* lds, const Ctx& C, int tile) {
    int tid_ = threadIdx.x; asm volatile("" : "+v"(tid_));
    const int tid = tid_, lane = tid & 63, wave = tid >> 6, fr = lane & 15, fq = lane >> 4;
    const int g = tile & 3, ck = (tile >> 2) & 31, b = tile >> 7;
    const size_t row_base = (size_t)b * SEQ + (size_t)ck * 128;
    bf16_t* WSL = (bf16_t*)lds;
    bf16_t* VT = (bf16_t*)(lds + 34816);
    bf16_t* SB = VT;
#pragma unroll
    for (int j = 0; j < 4; ++j) { const int q = tid + 512 * j, t = q >> 4, s8 = q & 15;
        *(u32x4*)(WSL + t * WS_LD + s8 * 8) = *(const u32x4*)(C.WSM + (size_t)g * 16384 + t * 128 + s8 * 8); }
    {
        const int wv = __builtin_amdgcn_readfirstlane(wave);
        u32x4 vv[4][2];
#pragma unroll
        for (int q = 0; q < 4; ++q) { const int ch = g * 256 + (4 * wv + q) * 8;
            vv[q][0] = __builtin_nontemporal_load((const u32x4*)(C.Z4 + (row_base + 2 * lane) * 4096 + 3072 + ch)); vv[q][1] = __builtin_nontemporal_load((const u32x4*)(C.Z4 + (row_base + 2 * lane + 1) * 4096 + 3072 + ch)); }
        f32x4 st = *(const f32x4*)(C.LNST + (row_base + 2 * lane) * 2);
        { const float m0 = st[0] * (1.0f / 1024.0f), m1 = st[2] * (1.0f / 1024.0f);
          st[1] = __builtin_amdgcn_rsqf(fmaxf(st[1] * (1.0f / 1024.0f) - m0 * m0, 0.f) + 1e-5f); st[3] = __builtin_amdgcn_rsqf(fmaxf(st[3] * (1.0f / 1024.0f) - m1 * m1, 0.f) + 1e-5f); st[0] = m0; st[2] = m1; }
#pragma unroll
        for (int q = 0; q < 4; ++q) { const int chl = (4 * wv + q) * 8, ch = g * 256 + chl;
            float v0[8], v1[8]; unpack8(vv[q][0], v0); unpack8(vv[q][1], v1);
            float lg[8], lb[8];
            { const f32x4 a0 = *(const f32x4*)(C.in[11] + ch), a1 = *(const f32x4*)(C.in[11] + ch + 4), b0 = *(const f32x4*)(C.in[12] + ch), b1 = *(const f32x4*)(C.in[12] + ch + 4);
#pragma unroll
              for (int j = 0; j < 4; ++j) { lg[j] = a0[j]; lg[4 + j] = a1[j]; lb[j] = b0[j]; lb[4 + j] = b1[j]; } }
#pragma unroll
            for (int j = 0; j < 8; ++j) { const float y0 = (v0[j] - st[0]) * st[1] * lg[j] + lb[j], y1 = (v1[j] - st[2]) * st[3] * lg[j] + lb[j];
                *(unsigned*)(VT + (chl + j) * WS_LD + 2 * lane) = cvt_pk_bf16(y0, y1); }
        }
    }
    __syncthreads();
    f32x4 acc[2][8];
#pragma unroll
    for (int n = 0; n < 2; ++n)
#pragma unroll
        for (int m = 0; m < 8; ++m) acc[n][m] = (f32x4){0.f, 0.f, 0.f, 0.f};
#pragma unroll
    for (int ks = 0; ks < 4; ++ks) {
        const bf16x8 b0 = *(const bf16x8*)(VT + (32 * wave + fr) * WS_LD + 32 * ks + 8 * fq), b1 = *(const bf16x8*)(VT + (32 * wave + 16 + fr) * WS_LD + 32 * ks + 8 * fq);
#pragma unroll
        for (int m = 0; m < 8; ++m) if (m >= 2 * ks) { const bf16x8 a = *(const bf16x8*)(WSL + (16 * m + fr) * WS_LD + 32 * ks + 8 * fq);
            acc[0][m] = __builtin_amdgcn_mfma_f32_16x16x32_bf16(a, b0, acc[0][m], 0, 0, 0);
            acc[1][m] = __builtin_amdgcn_mfma_f32_16x16x32_bf16(a, b1, acc[1][m], 0, 0, 0); }
    }
    __syncthreads();
    {
        const float* bs = C.in[14] + g * 128;
#pragma unroll
        for (int m = 0; m < 8; ++m) { const f32x4 bv = *(const f32x4*)(bs + 16 * m + 4 * fq);
#pragma unroll
            for (int n = 0; n < 2; ++n)
#pragma unroll
                for (int i = 0; i < 4; ++i) SB[(16 * m + 4 * fq + i) * XC_LD + 32 * wave + 16 * n + fr] = f_to_bf16(acc[n][m][i] + bv[i]); }
    }
    __syncthreads();
    {
        const int cc = tid & 31, tg = tid >> 5;
#pragma unroll
        for (int t4 = 0; t4 < 8; t4 += 4) {
        u32x4 uvv[4];
#pragma unroll
        for (int tt = 0; tt < 4; ++tt) uvv[tt] = __builtin_nontemporal_load((const u32x4*)(C.Z4 + (row_base + tg * 8 + t4 + tt) * 4096 + 2048 + g * 256 + cc * 8));
#pragma unroll
        for (int tt = 0; tt < 4; ++tt) { const int t = tg * 8 + t4 + tt;
            float sv[8], uv[8]; unpack8(*(const u32x4*)(SB + t * XC_LD + cc * 8), sv); unpack8(uvv[tt], uv);
            u32x4 pk; pk.x = cvt_pk_bf16(sv[0] * uv[0], sv[1] * uv[1]); pk.y = cvt_pk_bf16(sv[2] * uv[2], sv[3] * uv[3]); pk.z = cvt_pk_bf16(sv[4] * uv[4], sv[5] * uv[5]); pk.w = cvt_pk_bf16(sv[6] * uv[6], sv[7] * uv[7]);
            *(u32x4*)(C.YA + (row_base + t) * 2048 + 1024 + g * 256 + cc * 8) = pk; }
        asm volatile("" ::: "memory"); }
    }
    __syncthreads();
}

#define LAS __attribute__((address_space(3)))
#define XB_TMO      128
#define XB_XCNT(j)  (256  + 64 * (j))
#define XB_XSUB(j)  (1280 + 64 * (j))
#define XB_XGEN(j)  (2304 + 64 * (j))
#define XB_TOP      3328
#define XB_TOPGEN   3392
#define XCD_BAR_WORDS 3456
#define XB_SPIN_CAP (1u << 18)

__device__ __forceinline__ unsigned xb_ld(unsigned* p)              { return __hip_atomic_load(p, __ATOMIC_RELAXED, __HIP_MEMORY_SCOPE_AGENT); }
__device__ __forceinline__ unsigned xb_add(unsigned* p, unsigned v) { return __hip_atomic_fetch_add(p, v, __ATOMIC_RELAXED, __HIP_MEMORY_SCOPE_AGENT); }
__device__ __forceinline__ unsigned xb_xcc_id() { return (unsigned)__builtin_amdgcn_s_getreg((3 << 11) | 20) & 0xFu; }
#define XB_SPIN(cond, bar) do { unsigned _sp = 0; while (cond) { __builtin_amdgcn_s_sleep(1); \
    if ((++_sp & 255u) == 0u) { if (xb_ld(&(bar)[XB_TMO])) break; if (_sp > XB_SPIN_CAP) { atomicAdd(&(bar)[XB_TMO], 1u); break; } } } } while (0)

struct XcdBarrier {
    unsigned* bar; unsigned x;
    volatile LAS unsigned* st;
};

__device__ __forceinline__ XcdBarrier xcd_barrier_post(unsigned* bar, volatile LAS unsigned* st) {
    XcdBarrier b; b.bar = bar; b.x = xb_xcc_id(); b.st = st;
    if (threadIdx.x == 0) (void)xb_add(&bar[XB_XCNT(b.x)], 1u);
    return b;
}
__device__ __forceinline__ void xcd_barrier_complete(unsigned* bar, unsigned x, unsigned& nloc, unsigned& nx) {
    const unsigned G = gridDim.x * gridDim.y * gridDim.z;
    unsigned sum, cnt, mine, sp = 0u;
    for (;;) {
        sum = 0u; cnt = 0u; mine = 0u;
#pragma unroll
        for (unsigned j = 0; j < 16; ++j) { const unsigned c = xb_ld(&bar[XB_XCNT(j)]); sum += c; cnt += (c > 0u) ? 1u : 0u; mine = (j == x) ? c : mine; }
        if (sum == G) break;
        __builtin_amdgcn_s_sleep(1);
        if ((++sp & 255u) == 0u) { if (xb_ld(&bar[XB_TMO])) break; if (sp > XB_SPIN_CAP) { atomicAdd(&bar[XB_TMO], 1u); break; } }
    }
    nloc = mine > 0u ? mine : 1u; nx = cnt > 0u ? cnt : 1u;
}

__device__ __forceinline__ void xcd_barrier(const XcdBarrier& b) {
    asm volatile("s_waitcnt vmcnt(0)" ::: "memory");
    __syncthreads();
    if (threadIdx.x == 0) {
        unsigned* bar = b.bar;
        __builtin_amdgcn_s_waitcnt(0);
        unsigned nloc = b.st[0], nx = b.st[1];
        if (nloc == 0u) { xcd_barrier_complete(bar, b.x, nloc, nx); b.st[0] = nloc; b.st[1] = nx; }
        const unsigned old = xb_add(&bar[XB_XSUB(b.x)], 1u);
        const unsigned gen = old / nloc;
        if (old + 1u == (gen + 1u) * nloc) {
            __builtin_amdgcn_fence(__ATOMIC_RELEASE, "agent");
            asm volatile("s_waitcnt vmcnt(0)" ::: "memory");
            const unsigned og = xb_add(&bar[XB_TOP], 1u);
            const unsigned tg = og / nx;
            if (og + 1u == (tg + 1u) * nx) xb_add(&bar[XB_TOPGEN], 1u);
            else XB_SPIN(xb_ld(&bar[XB_TOPGEN]) == tg, bar);
            __builtin_amdgcn_fence(__ATOMIC_ACQUIRE, "agent");
            xb_add(&bar[XB_XGEN(b.x)], 1u);
            asm volatile("s_waitcnt vmcnt(0)" ::: "memory");
        } else {
            XB_SPIN(xb_ld(&bar[XB_XGEN(b.x)]) == gen, bar);
            __builtin_amdgcn_fence(__ATOMIC_ACQUIRE, "agent");
            asm volatile("s_waitcnt vmcnt(0)" ::: "memory");
        }
    }
    __syncthreads();
}
__global__ void __launch_bounds__(512, 2) hybrid_fwd(Params P) {
    extern __shared__ __attribute__((aligned(16))) unsigned char lds[];
    cg::grid_group grid = cg::this_grid();
    const int G = gridDim.x, NGW = G * 8;
    Ctx C;
#pragma unroll
    for (int i = 0; i < 21; ++i) C.in[i] = P.in[i];
    C.out = P.out; C.ws = P.ws;
    unsigned char* ws = P.ws;
    C.WIN = (bf16_t*)(ws + WS_WIN); C.WOA = (bf16_t*)(ws + WS_WOA); C.WOB = (bf16_t*)(ws + WS_WOB); C.WOUT = (bf16_t*)(ws + WS_WOUT); C.WUP = (bf16_t*)(ws + WS_WUP); C.WDN = (bf16_t*)(ws + WS_WDN);
    C.WG = (bf16_t*)(ws + WS_WG); C.WSM = (bf16_t*)(ws + WS_WSM); C.Z4 = (bf16_t*)(ws + WS_Z4); C.ZG = (bf16_t*)P.out; C.XN = (bf16_t*)(ws + WS_XN + 1 * MiB + 8192); C.YA = (bf16_t*)(ws + WS_YA); C.YB = (bf16_t*)(ws + WS_YB);
    C.MRG = (bf16_t*)(ws + WS_MRG); C.H1B = (bf16_t*)(ws + WS_H1B); C.U = (bf16_t*)(ws + WS_U);
    C.SUMA = (float*)(ws + WS_SUMA); C.SUMB = (float*)(ws + WS_SUMB); C.LNST = (float*)(ws + WS_LNST); C.SS1 = (float*)(ws + WS_SS1); C.SS2 = (float*)(ws + WS_SS2); C.TMP = (float*)(ws + WS_TMP); C.MASK = (unsigned*)(ws + WS_BAR) + 4096;
    PG8_LAS unsigned char* ldsl = (PG8_LAS unsigned char*)lds;
    volatile LAS unsigned* bst = (volatile LAS unsigned*)(ldsl + LDS_BYTES - 16);
    if (threadIdx.x < 4) bst[threadIdx.x] = 0u;
    __syncthreads();
    const XcdBarrier bar = xcd_barrier_post((unsigned*)(ws + WS_BAR), bst);
    if (G > 65535) grid.sync();
#define GRID_BAR() xcd_barrier(bar)

    {
        int t0_ = threadIdx.x; asm volatile("" : "+v"(t0_)); const int tid = t0_, lane = tid & 63, wave = tid >> 6, gw = blockIdx.x * 8 + wave;
        float* scr = (float*)(lds + wave * 8448);
        constexpr int I_IN = 16 * 192, I_SQ = 16 * 32, I_UP = 16 * 128, I_DN = 64 * 32, I_G = 4 * 8;
        constexpr int NITEMS = I_IN + 3 * I_SQ + I_UP + I_DN + 8 * I_G;
        for (int it = gw; it < NITEMS; it += NGW) {
            int r = it;
            if (r < I_IN) { tr_item(C.in[2], DIN, DM, C.WIN, nullptr, scr, r, lane); continue; } r -= I_IN;
            if (r < I_SQ) { tr_item(C.in[10], DM, DM, C.WOA, nullptr, scr, r, lane, 2048); continue; } r -= I_SQ;
            if (r < I_SQ) { tr_item(C.in[15], DM, DM, C.WOA + 1024, nullptr, scr, r, lane, 2048); continue; } r -= I_SQ;
            if (r < I_SQ) { tr_item(C.in[16], DM, DM, C.WOUT, nullptr, scr, r, lane); continue; } r -= I_SQ;
            if (r < I_UP) { tr_item(C.in[18], DFF, DM, C.WUP, C.in[17], scr, r, lane); continue; } r -= I_UP;
            if (r < I_DN) { tr_item(C.in[19], DM, DFF, C.WDN, nullptr, scr, r, lane); continue; } r -= I_DN;
            { const int mat = r / I_G, item = r % I_G, hh = mat >> 1, gate = mat & 1;
              tr_item(C.in[gate ? 7 : 5] + (size_t)hh * 65536, 256, 256, C.WG + (size_t)(hh * 2 + gate) * 65536, nullptr, scr, item, lane); }
        }
        for (int i = blockIdx.x * 512 + tid; i < 4 * 128 * 128; i += G * 512) { const int t = (i >> 7) & 127, s = i & 127; C.WSM[i] = (s <= t) ? pg8::cvt_pk_bf16(C.in[13][i], 0.f) & 0xffffu : 0; }
        for (int i = blockIdx.x * 512 + tid; i < MTOK; i += G * 512) { C.SS1[i] = 0.f; C.SS2[i] = 0.f; C.LNST[2 * i] = 0.f; C.LNST[2 * i + 1] = 0.f; }
        for (int m = gw; m < MTOK; m += 2 * NGW) {
            const int m2 = m + NGW;
            if (m2 < MTOK) rms_rows2_to_bf16(C.in[0] + (size_t)m * DM, C.in[0] + (size_t)m2 * DM, C.in[1], C.XN + (size_t)m * DM, C.XN + (size_t)m2 * DM, lane);
            else rms_row_to_bf16(C.in[0] + (size_t)m * DM, C.in[1], C.XN + (size_t)m * DM, lane);
        }
    }
    GRID_BAR();
    { pg8::Gemm g{C.XN, C.WIN, MTOK, DIN, DM}; pg8::StaticOrder S; S.init(MTOK, DIN, G, (int)blockIdx.x, (blockIdx.x & 1) ? 3 : 0);
      pg8::EpiZ E{C.Z4, C.ZG, C.LNST};
      pg8::gemm_phase<pg8::EpiZ, pg8::StaticOrder, true, true>(ldsl, g, S, E); }
    GRID_BAR();
    if (blockIdx.x & 2) for (int t = blockIdx.x; t < 512; t += G) mixer_b_tile(lds, C, t);
    for (int t = blockIdx.x; t < 512; t += G) mixer_a_tile(lds, C, t);
    if (!(blockIdx.x & 2)) for (int t = blockIdx.x; t < 512; t += G) mixer_b_tile(lds, C, t);
    GRID_BAR();
    { pg8::Gemm g{C.YA, C.WOA, MTOK, DM, 2 * DM}; pg8::StaticOrder S; S.init(MTOK, DM, G, (int)blockIdx.x);
      pg8::EpiMerge2 E{(const unsigned char*)C.ZG, C.MRG};
      pg8::gemm_phase<pg8::EpiMerge2, pg8::StaticOrder, true, true>(ldsl, g, S, E); }
    GRID_BAR();
    { pg8::Gemm g{C.MRG, C.WOUT, MTOK, DM, DM}; pg8::StaticOrder S; S.init(MTOK, DM, G, (int)blockIdx.x);
      pg8::EpiH1 E{C.in[0], C.out, C.H1B, C.SS1, G == 256 ? 0 : 1};
      pg8::gemm_phase<pg8::EpiH1, pg8::StaticOrder, true, true>(ldsl, g, S, E); }
    GRID_BAR();
    { pg8::Gemm g{C.H1B, C.WUP, MTOK, DFF, DM}; pg8::StaticOrder S; S.init(MTOK, DFF, G, (int)blockIdx.x);
      pg8::EpiUp E{C.SS1, C.U};
      pg8::gemm_phase<pg8::EpiUp, pg8::StaticOrder, true, true>(ldsl, g, S, E); }
    GRID_BAR();
    if (G == 256) {
      pg8::Gemm g{C.U, C.WDN, MTOK, DM, DFF}; pg8::StaticOrder S; S.init(MTOK, DM, G, (int)blockIdx.x);
      pg8::EpiDownNorm E{C.H1B, C.out, C.SS2, C.MASK + 1024, C.in[20]};
      pg8::gemm_phase<pg8::EpiDownNorm, pg8::StaticOrder, false, true>(ldsl, g, S, E);
    } else {
      { pg8::Gemm g{C.U, C.WDN, MTOK, DM, DFF}; pg8::StaticOrder S; S.init(MTOK, DM, G, (int)blockIdx.x);
        pg8::EpiDown E{C.out, C.SS2};
        pg8::gemm_phase<pg8::EpiDown, pg8::StaticOrder, true, true>(ldsl, g, S, E); }
      GRID_BAR();
      int t8_ = threadIdx.x; asm volatile("" : "+v"(t8_)); const int lane = t8_ & 63, gw = blockIdx.x * 8 + (t8_ >> 6);
      for (int m = gw; m < MTOK; m += NGW) {
        f32x4* xr = (f32x4*)(C.out + (size_t)m * DM) + lane; const f32x4* gr = (const f32x4*)C.in[20] + lane;
        const float rs = 1.0f / sqrtf(C.SS2[m] * (1.0f / 1024.0f) + 1e-6f);
#pragma unroll
        for (int j = 0; j < 4; ++j) xr[64 * j] = xr[64 * j] * rs * gr[64 * j];
      }
    }
}

extern "C" void kernel_launch(void* const* d_in, const int* in_sizes, int n_in, void* d_out, int out_size, void* d_ws, size_t ws_size, hipStream_t stream) {
    static int grid_blocks = 0;
    if (grid_blocks == 0) {
        if (n_in != 21 || out_size != MTOK * DM || ws_size < WS_END) { fprintf(stderr, "kernel_launch: unexpected shapes (n_in %d, out %d, ws %zu)\n", n_in, out_size, ws_size); grid_blocks = -1; return; }
        int dev = 0, cus = 0, per_cu = 0;
        hipGetDevice(&dev); hipDeviceGetAttribute(&cus, hipDeviceAttributeMultiprocessorCount, dev);
        if (hipFuncSetAttribute((const void*)hybrid_fwd, hipFuncAttributeMaxDynamicSharedMemorySize, LDS_BYTES) != hipSuccess) fprintf(stderr, "kernel_launch: hipFuncSetAttribute failed\n");
        if (hipOccupancyMaxActiveBlocksPerMultiprocessor(&per_cu, (const void*)hybrid_fwd, 512, LDS_BYTES) != hipSuccess || per_cu < 1) { fprintf(stderr, "kernel_launch: occupancy query says %d\n", per_cu); per_cu = 1; }
        (void)hipGetLastError();
        grid_blocks = cus * 1;
    }
    if (grid_blocks < 0) return;
    Params p{};
    for (int i = 0; i < 21; ++i) p.in[i] = (const float*)d_in[i];
    p.out = (float*)d_out; p.ws = (unsigned char*)d_ws;
    if (hipMemsetAsync((char*)d_ws + WS_BAR, 0, (4096 + 1024 + 64 * 64) * sizeof(unsigned), stream) != hipSuccess) { fprintf(stderr, "kernel_launch: memset failed\n"); return; }
    void* args[] = {&p};
    hipError_t e = hipLaunchCooperativeKernel((const void*)hybrid_fwd, dim3(grid_blocks), dim3(512), args, LDS_BYTES, stream);
    if (e != hipSuccess) fprintf(stderr, "cooperative launch failed: %s (grid %d)\n", hipGetErrorString(e), grid_blocks);
}
```
